# Optimizing an MI355X kernel written in HIP

```python
import jax, jax.numpy as jnp
from jax import lax
import numpy as np

D_MODEL = 1024
BATCH = 4
SEQ = 8192
DEPTH = 2
DEC_BATCH = 16
DEC_SEQ = 32
PAST_LEN = 2048

CHUNK = 64
N_A_LAYERS = DEPTH // 2
N_B_LAYERS = DEPTH - N_A_LAYERS
A_EXPAND = 128
A_HEADS = D_MODEL // A_EXPAND
A_DK = A_EXPAND
A_DV = D_MODEL // A_HEADS
B_HEAD_DIM = 64
B_Q_HEADS = D_MODEL // B_HEAD_DIM
B_KV_HEADS = 4
B_GROUP = B_Q_HEADS // B_KV_HEADS
WINDOW = 128
WIN_CHUNKS = WINDOW // CHUNK
D_FF = -(-8 * D_MODEL // (3 * 256)) * 256
ROPE_THETA = 10000.0
NORM_EPS = 1e-6

kernel_name = "hgrn2_yoco_swa_sink_stream_step"

F32 = jnp.float32


def rms_norm(x, w):
    xf = x.astype(F32)
    y = xf * lax.rsqrt(jnp.mean(xf * xf, axis=-1, keepdims=True) + NORM_EPS)
    return (y * w.astype(F32)).astype(x.dtype)


def rope(x, pos):
    half = x.shape[-1] // 2
    inv = ROPE_THETA ** (-jnp.arange(half, dtype=F32) / half)
    ang = pos.astype(F32)[:, None] * inv[None, :]
    cos = jnp.cos(ang)[:, None, :]
    sin = jnp.sin(ang)[:, None, :]
    xf = x.astype(F32)
    x1, x2 = xf[..., :half], xf[..., half:]
    return jnp.concatenate([x1 * cos - x2 * sin, x2 * cos + x1 * sin], axis=-1).astype(x.dtype)


def hgrn2_block(S, blk):
    q, k, v, lf = blk
    L = q.shape[1]
    b = jnp.cumsum(lf, axis=1)
    o_inter = jnp.einsum('blhk,bhkv->blhv', q * jnp.exp(b), S)
    causal = jnp.tril(jnp.ones((L, L), dtype=bool))
    e = b[:, :, None] - b[:, None, :]
    decay = jnp.exp(jnp.where(causal[None, :, :, None, None], e, -jnp.inf))
    scores = jnp.einsum('btshk,bshk->bhts', decay * q[:, :, None], k)
    o_intra = jnp.einsum('bhts,bshv->bthv', scores, v)
    b_last = b[:, -1]
    S_new = jnp.exp(b_last)[..., None] * S + jnp.einsum(
        'bshk,bshv->bhkv', k * jnp.exp(b_last[:, None] - b), v)
    return S_new, o_inter + o_intra


def hgrn2_scan(q, k, v, lf, S0, block_len):
    B, T = q.shape[:2]
    n = T // block_len

    def split(a):
        return a.reshape(B, n, block_len, *a.shape[2:]).swapaxes(0, 1)

    S, o = lax.scan(hgrn2_block, S0, (split(q), split(k), split(v), split(lf)))
    o = o.swapaxes(0, 1).reshape(B, T, A_HEADS, A_DV)
    return o, S


def hgrn2_mixer(h, w_in, lb, g_norm, w_out, S0, block_len):
    B, T, _ = h.shape
    q, f, i, g = jnp.split(h @ w_in, 4, axis=-1)
    lbf = lb.astype(F32)
    forget = lbf + (1.0 - lbf) * jax.nn.sigmoid(f.astype(F32))
    lf = jnp.log(forget)
    inp = 1.0 - forget
    shp = (B, T, A_HEADS, A_DK)
    o, S = hgrn2_scan(jax.nn.silu(q.astype(F32)).reshape(shp), inp.reshape(shp),
                      i.astype(F32).reshape(B, T, A_HEADS, A_DV), lf.reshape(shp),
                      S0.astype(F32), block_len)
    o = rms_norm(o, g_norm) * jax.nn.silu(g.astype(F32)).reshape(B, T, A_HEADS, A_DV)
    return o.reshape(B, T, D_MODEL).astype(h.dtype) @ w_out, S


def sink_attention(q, k, v, sinks, valid):
    s = jnp.einsum('bnqkgd,bnskd->bnkgqs', q.astype(F32), k.astype(F32)) * (B_HEAD_DIM ** -0.5)
    s = jnp.where(valid[None, :, None, None, None, :], s, -jnp.inf)
    sink = sinks.astype(F32).reshape(1, 1, B_KV_HEADS, B_GROUP, 1, 1)
    m = jnp.maximum(jnp.max(s, axis=-1, keepdims=True), sink)
    p = jnp.exp(s - m)
    denom = jnp.sum(p, axis=-1, keepdims=True) + jnp.exp(sink - m)
    return jnp.einsum('bnkgqs,bnskd->bnqkgd', p / denom, v.astype(F32))


def window_attention_prompt(q, k, v, sinks):
    B, T = q.shape[:2]
    n = T // CHUNK
    qb = q.reshape(B, n, CHUNK, B_KV_HEADS, B_GROUP, B_HEAD_DIM)

    def band(a):
        ap = jnp.pad(a, ((0, 0), (WIN_CHUNKS * CHUNK, 0), (0, 0), (0, 0)))
        ap = ap.reshape(B, n + WIN_CHUNKS, CHUNK, B_KV_HEADS, B_HEAD_DIM)
        return jnp.concatenate([ap[:, j:j + n] for j in range(WIN_CHUNKS + 1)], axis=2)

    key_pos = (jnp.arange(n)[:, None] - WIN_CHUNKS) * CHUNK + jnp.arange((WIN_CHUNKS + 1) * CHUNK)[None, :]
    o = sink_attention(qb, band(k), band(v), sinks, key_pos >= 0)
    return o.reshape(B, T, B_Q_HEADS * B_HEAD_DIM)


def window_attention_sample(q, k_all, v_all, sinks):
    B, T = q.shape[:2]
    Lk = k_all.shape[1]
    o = sink_attention(q.reshape(B, 1, T, B_KV_HEADS, B_GROUP, B_HEAD_DIM),
                       k_all[:, None], v_all[:, None], sinks, jnp.ones((1, Lk), dtype=bool))
    return o.reshape(B, T, B_Q_HEADS * B_HEAD_DIM)


def run_trunk(x, pos, hgrn_state, cache_k, cache_v, block_len,
              norm_mix_pre, norm_mix_post, norm_ffn_pre, norm_ffn_post, w_ffn_in, w_ffn_out,
              w_a_in, a_lower_bound, a_out_norm, w_a_out, kv_norm, w_kv, w_b_q, b_sinks, w_b_out):
    B, T, _ = x.shape
    lower = jnp.cumsum(jax.nn.softmax(a_lower_bound.astype(F32), axis=0), axis=0)
    new_states = []
    k_attn = v_attn = None
    for layer in range(DEPTH):
        h = rms_norm(x, norm_mix_pre[layer])
        if layer < N_A_LAYERS:
            mix, S = hgrn2_mixer(h, w_a_in[layer], lower[layer], a_out_norm[layer], w_a_out[layer],
                                 hgrn_state[layer], block_len)
            new_states.append(S.astype(x.dtype))
        else:
            if layer == N_A_LAYERS:
                k, v = jnp.split(rms_norm(x, kv_norm) @ w_kv, 2, axis=-1)
                k = rope(k.reshape(B, T, B_KV_HEADS, B_HEAD_DIM), pos)
                v = v.reshape(B, T, B_KV_HEADS, B_HEAD_DIM)
                if cache_k is None:
                    k_attn, v_attn = k, v
                else:
                    k_attn = jnp.concatenate([cache_k.astype(k.dtype), k], axis=1)
                    v_attn = jnp.concatenate([cache_v.astype(v.dtype), v], axis=1)
            j = layer - N_A_LAYERS
            q = rope((h @ w_b_q[j]).reshape(B, T, B_Q_HEADS, B_HEAD_DIM), pos)
            if cache_k is None:
                o = window_attention_prompt(q, k_attn, v_attn, b_sinks[j])
            else:
                o = window_attention_sample(q, k_attn, v_attn, b_sinks[j])
            mix = o.astype(x.dtype) @ w_b_out[j]
        x = x + rms_norm(mix, norm_mix_post[layer])
        hf = rms_norm(x, norm_ffn_pre[layer])
        a, b = jnp.split(hf @ w_ffn_in[layer], 2, axis=-1)
        x = x + rms_norm((jax.nn.silu(a) * b) @ w_ffn_out[layer], norm_ffn_post[layer])
    return x, jnp.stack(new_states), k_attn[:, -WINDOW:], v_attn[:, -WINDOW:]


def setup_inputs(seed: int = 0) -> dict:
    key = jax.random.key(seed)
    ks = jax.random.split(key, 24)
    nrm = jax.random.normal
    D = D_MODEL
    QW = B_Q_HEADS * B_HEAD_DIM
    KVW = B_KV_HEADS * B_HEAD_DIM
    return {
        "x_prompt": nrm(ks[0], (BATCH, SEQ, D), F32),
        "x_sample": nrm(ks[1], (DEC_BATCH, DEC_SEQ, D), F32),
        "state_hgrn": 0.5 * nrm(ks[2], (N_A_LAYERS, DEC_BATCH, A_HEADS, A_DK, A_DV), F32),
        "cache_k": nrm(ks[3], (DEC_BATCH, WINDOW, B_KV_HEADS, B_HEAD_DIM), F32),
        "cache_v": nrm(ks[4], (DEC_BATCH, WINDOW, B_KV_HEADS, B_HEAD_DIM), F32),
        "norm_mix_pre": 1.0 + 0.05 * nrm(ks[5], (DEPTH, D), F32),
        "norm_mix_post": 1.0 + 0.05 * nrm(ks[6], (DEPTH, D), F32),
        "norm_ffn_pre": 1.0 + 0.05 * nrm(ks[7], (DEPTH, D), F32),
        "norm_ffn_post": 1.0 + 0.05 * nrm(ks[8], (DEPTH, D), F32),
        "w_ffn_in": nrm(ks[9], (DEPTH, D, 2 * D_FF), F32) * D ** -0.5,
        "w_ffn_out": nrm(ks[10], (DEPTH, D_FF, D), F32) * D_FF ** -0.5,
        "w_a_in": nrm(ks[11], (N_A_LAYERS, D, 4 * D), F32) * D ** -0.5,
        "a_lower_bound": 0.1 * nrm(ks[12], (DEPTH, D), F32),
        "a_out_norm": 1.0 + 0.05 * nrm(ks[13], (N_A_LAYERS, A_HEADS, A_DV), F32),
        "w_a_out": nrm(ks[14], (N_A_LAYERS, D, D), F32) * D ** -0.5,
        "kv_norm": 1.0 + 0.05 * nrm(ks[15], (D,), F32),
        "w_kv": nrm(ks[16], (D, 2 * KVW), F32) * D ** -0.5,
        "w_b_q": nrm(ks[17], (N_B_LAYERS, D, QW), F32) * D ** -0.5,
        "b_sinks": 0.5 * nrm(ks[18], (N_B_LAYERS, B_Q_HEADS), F32),
        "w_b_out": nrm(ks[19], (N_B_LAYERS, QW, D), F32) * QW ** -0.5,
    }


def reference(x_prompt, x_sample, state_hgrn, cache_k, cache_v,
              norm_mix_pre, norm_mix_post, norm_ffn_pre, norm_ffn_post, w_ffn_in, w_ffn_out,
              w_a_in, a_lower_bound, a_out_norm, w_a_out, kv_norm, w_kv, w_b_q, b_sinks, w_b_out):
    weights = (norm_mix_pre, norm_mix_post, norm_ffn_pre, norm_ffn_post, w_ffn_in, w_ffn_out,
               w_a_in, a_lower_bound, a_out_norm, w_a_out, kv_norm, w_kv, w_b_q, b_sinks, w_b_out)
    Bp, Tp, _ = x_prompt.shape
    Ts = x_sample.shape[1]
    pos_prompt = jnp.arange(Tp)
    pos_sample = PAST_LEN + jnp.arange(Ts)
    zero_state = jnp.zeros((N_A_LAYERS, Bp, A_HEADS, A_DK, A_DV), x_prompt.dtype)
    y_prompt, st_p, k_p, v_p = run_trunk(x_prompt, pos_prompt, zero_state, None, None, CHUNK, *weights)
    y_sample, st_s, k_s, v_s = run_trunk(x_sample, pos_sample, state_hgrn, cache_k, cache_v, Ts, *weights)
    return (y_prompt, y_sample, st_p, st_s, k_p, v_p, k_s, v_s)
```

```cpp
#include <hip/hip_runtime.h>
#include <hip/hip_cooperative_groups.h>
#include <cstdio>
#include <cstdint>
namespace cg = cooperative_groups;

#ifndef MK_ONE_LAUNCH
#define MK_ONE_LAUNCH 1
#endif

#define LAS __attribute__((address_space(3)))
typedef unsigned short bf16_t;
typedef short bf16x8 __attribute__((ext_vector_type(8)));
typedef float f32x4 __attribute__((ext_vector_type(4)));
typedef float f32x2 __attribute__((ext_vector_type(2)));
typedef float f32x16 __attribute__((ext_vector_type(16)));
typedef unsigned u32x4 __attribute__((ext_vector_type(4)));
typedef unsigned u32x2 __attribute__((ext_vector_type(2)));

constexpr int D = 1024, TP = 8192, MP = 32768, MS = 512, MT = MP + MS, DFF = 2816;
constexpr float EPS = 1e-6f;
constexpr size_t MiB = 1u << 20;
constexpr size_t WS_W1 = 0, WS_W2 = 8 * MiB, WS_W3 = 10 * MiB, WS_W4 = 21 * MiB, WS_W5 = 27 * MiB, WS_W6 = 30 * MiB, WS_W7 = 32 * MiB, WS_W8 = 43 * MiB;
constexpr size_t WS_ROPE = 49 * MiB, WS_RS = 51 * MiB, WS_LB = 51 * MiB + 512 * 1024, WS_SSQ = 52 * MiB;
constexpr size_t WS_XB = 56 * MiB, WS_XR = 121 * MiB, WS_ST = 121 * MiB;
constexpr size_t WS_BIG = 251 * MiB;
constexpr size_t WS_QH = WS_BIG, WS_KK = WS_BIG + 33 * MiB, WS_VV = WS_BIG + 66 * MiB, WS_GG = WS_BIG + 99 * MiB, WS_BB = WS_BIG + 132 * MiB;
constexpr size_t WS_MIX = WS_BIG, WS_H = WS_BIG + 65 * MiB;
constexpr size_t WS_KB = WS_BIG + 65 * MiB, WS_VB = WS_BIG + 82 * MiB, WS_QB = WS_BIG + 99 * MiB;
constexpr size_t WS_END = WS_BIG + 244 * MiB;
constexpr size_t OUT_Y = 0, OUT_STP = 34078720, OUT_STS = 34603008, OUT_CKP = 36700160, OUT_CVP = 36831232, OUT_CKS = 36962304, OUT_CVS = 37486592;

constexpr int LDS_BYTES = 131072;

struct Params { const float* in[20]; float* out; unsigned char* ws; };
typedef const Params __attribute__((address_space(4)))* KP;
__device__ __forceinline__ KP kparams() { KP k = (KP)__builtin_amdgcn_kernarg_segment_ptr(); asm volatile("" : "+s"(k)); return k; }

__device__ __forceinline__ unsigned pk2(float lo, float hi) { unsigned r; asm("v_cvt_pk_bf16_f32 %0, %1, %2" : "=v"(r) : "v"(lo), "v"(hi)); return r; }
__device__ __forceinline__ float bflo(unsigned u) { return __uint_as_float(u << 16); }
__device__ __forceinline__ float bfhi(unsigned u) { return __uint_as_float(u & 0xffff0000u); }
__device__ __forceinline__ float frcp(float x) { return __builtin_amdgcn_rcpf(x); }
__device__ __forceinline__ float siluf(float v) { float c = fminf(fmaxf(v, -30.f), 30.f); return v * frcp(1.f + __expf(-c)); }
__device__ __forceinline__ float wave_sum(float v) {
#pragma unroll
    for (int o = 1; o < 64; o <<= 1) v += __shfl_xor(v, o);
    return v;
}
#define LDS_WAIT() asm volatile("s_waitcnt lgkmcnt(0)" ::: "memory")
__device__ __forceinline__ int o_tid() { int t = threadIdx.x; asm volatile("" : "+v"(t)); return t; }
__device__ __forceinline__ int o_bid() { int t = blockIdx.x; asm volatile("" : "+s"(t)); return t; }
__device__ __forceinline__ int o_grid() { int t = gridDim.x; asm volatile("" : "+s"(t)); return t; }

namespace pg8 {
constexpr int BM = 256, BK = 64, HALF = 128, HTB = HALF * BK * 2, STAGE_BYTES = 8 * HTB, NXCD = 8, WGM = 8;
__host__ __device__ __forceinline__ int lds_byte(int r, int c) { const int st = (r >> 4) * 2 + (c >> 5), rr = r & 15, cc = c & 31, ob = rr * 64 + cc * 2; return st * 1024 + (ob ^ (((ob >> 9) & 1) << 5)); }
__host__ __device__ __forceinline__ void stage_rc(int b, int& R, int& C) { const int st = b / 1024, sb = b % 1024, swz = sb ^ (((sb >> 9) & 1) << 5); R = (st >> 1) * 16 + swz / 64; C = (st & 1) * 32 + (swz % 64) / 2; }
__host__ __device__ __forceinline__ int perm32(int rho) { const int n = rho >> 4, i = rho & 15; return 8 * (i >> 2) + 4 * n + (i & 3); }
struct Unit { int pm, pn; };
struct Gemm { const bf16_t* A; const bf16_t* Bt; int M, N, K; };
struct StaticOrder {
    int nM, nN, nwg, G, c;
    __device__ void init(int M, int N, int G_, int c_) { nM = M / BM; nN = N / BM; nwg = nM * nN; G = G_; c = c_; }
    __device__ bool next(int i, Unit& u) const {
        const long L = (long)i * G + c; if (L >= nwg) return false;
        int wgid = (int)L; { const int q = nwg / NXCD, r = nwg % NXCD, xcd = wgid % NXCD, off = wgid / NXCD; wgid = (xcd < r ? xcd * (q + 1) : r * (q + 1) + (xcd - r) * q) + off; }
        const int nig = WGM * nN, gid = wgid / nig, fm = gid * WGM, gsz = (nM - fm) < WGM ? (nM - fm) : WGM;
        u.pm = fm + ((wgid % nig) % gsz); u.pn = (wgid % nig) / gsz; return true;
    }
};
template <class Epi>
__device__ __forceinline__ void gemm_phase(LAS unsigned char* lds, const Gemm g, const StaticOrder& S, const Epi& E) {
    const int tid = o_tid(), wid = __builtin_amdgcn_readfirstlane(tid >> 6), lane = tid & 63, wr = wid >> 2, wc = wid & 3, fr = lane & 15, fq = lane >> 4;
    const int K = g.K, nt = K / BK;
    unsigned voffA[2], voffB[2];
#pragma unroll
    for (int i = 0; i < 2; ++i) { int R, C; stage_rc(tid * 16 + i * 8192, R, C); const int Rb = (R & ~31) + perm32(R & 31);
        voffA[i] = (unsigned)(R * K + C) * 2u; voffB[i] = (unsigned)(Rb * K + C) * 2u; }
    const size_t kstep = (size_t)(BK * 2);
    const size_t hstep = (size_t)HALF * K * 2;
    const size_t tstep = 2 * hstep;
    const unsigned ldsw = (unsigned)wid * 1024u;
    const int aoff = lds_byte(wr * 64 + fr, fq * 8), boff = lds_byte(wc * 32 + fr, fq * 8);
#define PG8_SA(b, h) (((b) * 2 + (h)) * HTB)
#define PG8_SB(b, h) ((4 + (b) * 2 + (h)) * HTB)
#define PG8_STAGE(bufoff, gbase, voff) do { _Pragma("unroll") for (int _i = 0; _i < 2; ++_i) \
        __builtin_amdgcn_global_load_lds((const unsigned*)((const char*)(gbase) + (voff)[_i]), (LAS unsigned*)(lds + (bufoff) + ldsw + _i * 8192), 16, 0, 0); } while (0)
#define PG8_LDA(dst, b, h) do { _Pragma("unroll") for (int m = 0; m < 4; ++m) _Pragma("unroll") for (int k = 0; k < 2; ++k) dst[m][k] = *(const LAS bf16x8*)(lds + PG8_SA(b, h) + aoff + m * 2048 + k * 1024); } while (0)
#define PG8_LDB(dst, b, h) do { _Pragma("unroll") for (int n = 0; n < 2; ++n) _Pragma("unroll") for (int k = 0; k < 2; ++k) dst[n][k] = *(const LAS bf16x8*)(lds + PG8_SB(b, h) + boff + n * 2048 + k * 1024); } while (0)
#define PG8_MMA(ai, bj, At, Bt) do { __builtin_amdgcn_s_setprio(1); _Pragma("unroll") for (int m = 0; m < 4; ++m) _Pragma("unroll") for (int n = 0; n < 2; ++n) _Pragma("unroll") for (int k = 0; k < 2; ++k) \
        acc[ai][bj][m][n] = __builtin_amdgcn_mfma_f32_16x16x32_bf16(Bt[n][k], At[m][k], acc[ai][bj][m][n], 0, 0, 0); __builtin_amdgcn_s_setprio(0); } while (0)
#define PG8_WAIT_V(n) asm volatile("s_waitcnt vmcnt(" #n ")" ::: "memory")
#define PG8_WAIT_L(n) asm volatile("s_waitcnt lgkmcnt(" #n ")" ::: "memory")
#define PG8_BAR __builtin_amdgcn_s_barrier()
#define PG8_SCHED __builtin_amdgcn_sched_barrier(0)
    Unit cur, nxt; int ui = 0;
    if (!S.next(0, cur)) return;
    f32x4 acc[2][2][4][2];
#pragma unroll
    for (int a = 0; a < 2; ++a)
#pragma unroll
        for (int b = 0; b < 2; ++b)
#pragma unroll
            for (int m = 0; m < 4; ++m)
#pragma unroll
                for (int n = 0; n < 2; ++n) acc[a][b][m][n] = (f32x4){0.f, 0.f, 0.f, 0.f};
    bf16x8 At[4][2], B0[2][2], B1[2][2];
    const char* cA = (const char*)g.A + (size_t)cur.pm * tstep; const char* cB = (const char*)g.Bt + (size_t)cur.pn * tstep;
    PG8_STAGE(PG8_SB(0, 0), cB, voffB); PG8_STAGE(PG8_SB(0, 1), cB + hstep, voffB); PG8_STAGE(PG8_SA(0, 0), cA, voffA); PG8_STAGE(PG8_SA(0, 1), cA + hstep, voffA);
    if (wr == 1) PG8_BAR;
    PG8_WAIT_V(2); PG8_BAR;
    PG8_STAGE(PG8_SB(1, 0), cB + kstep, voffB); PG8_STAGE(PG8_SA(1, 0), cA + kstep, voffA); PG8_STAGE(PG8_SB(1, 1), cB + hstep + kstep, voffB);
    PG8_WAIT_V(6); PG8_BAR;
    for (;;) {
        const bool has_next = S.next(ui + 1, nxt);
        const char* nA = has_next ? (const char*)g.A + (size_t)nxt.pm * tstep : cA; const char* nB = has_next ? (const char*)g.Bt + (size_t)nxt.pn * tstep : cB;
        for (int t = 0; t < nt; t += 2) {
            const bool last = (t == nt - 2);
            const char* a1 = cA + (size_t)(t + 1) * kstep;
            const char* a2 = last ? nA : cA + (size_t)(t + 2) * kstep; const char* b2 = last ? nB : cB + (size_t)(t + 2) * kstep;
            const char* a3 = a2 + kstep; const char* b3 = b2 + kstep;
            PG8_LDB(B0, 0, 0); PG8_LDB(B1, 0, 1); PG8_SCHED; PG8_LDA(At, 0, 0); PG8_STAGE(PG8_SA(1, 1), a1 + hstep, voffA);
            PG8_WAIT_V(8); PG8_WAIT_L(0); PG8_BAR; PG8_MMA(0, 0, At, B0); PG8_MMA(0, 1, At, B1); PG8_BAR; PG8_SCHED;
            PG8_LDA(At, 0, 1); PG8_STAGE(PG8_SB(0, 0), b2, voffB); PG8_STAGE(PG8_SB(0, 1), b2 + hstep, voffB); PG8_STAGE(PG8_SA(0, 0), a2, voffA);
            PG8_WAIT_V(8); PG8_WAIT_L(0); PG8_BAR; PG8_MMA(1, 0, At, B0); PG8_MMA(1, 1, At, B1); PG8_BAR; PG8_SCHED;
            PG8_LDB(B0, 1, 0); PG8_LDB(B1, 1, 1); PG8_SCHED; PG8_LDA(At, 1, 0); PG8_STAGE(PG8_SA(0, 1), a2 + hstep, voffA);
            PG8_WAIT_V(8); PG8_WAIT_L(0); PG8_BAR; PG8_MMA(0, 0, At, B0); PG8_MMA(0, 1, At, B1); PG8_BAR; PG8_SCHED;
            PG8_LDA(At, 1, 1); PG8_STAGE(PG8_SB(1, 0), b3, voffB); PG8_STAGE(PG8_SB(1, 1), b3 + hstep, voffB); PG8_STAGE(PG8_SA(1, 0), a3, voffA);
            PG8_WAIT_V(8); PG8_WAIT_L(0); PG8_BAR; PG8_MMA(1, 0, At, B0); PG8_MMA(1, 1, At, B1); PG8_BAR; PG8_SCHED;
        }
        if (wr == 0) PG8_BAR;
        E(acc, cur, wr, wc, fr, fq);
        if (!has_next) break;
#pragma unroll
        for (int a = 0; a < 2; ++a)
#pragma unroll
            for (int b = 0; b < 2; ++b)
#pragma unroll
                for (int m = 0; m < 4; ++m)
#pragma unroll
                    for (int n = 0; n < 2; ++n) acc[a][b][m][n] = (f32x4){0.f, 0.f, 0.f, 0.f};
        cur = nxt; cA = nA; cB = nB; ++ui;
        if (wr == 1) PG8_BAR;
    }
    PG8_WAIT_V(0);
    PG8_BAR;
#undef PG8_SA
#undef PG8_SB
#undef PG8_STAGE
#undef PG8_LDA
#undef PG8_LDB
#undef PG8_MMA
#undef PG8_WAIT_V
#undef PG8_WAIT_L
#undef PG8_BAR
#undef PG8_SCHED
}
}
using pg8::Unit;

__device__ __forceinline__ u32x4 pack8(const f32x4 a, const f32x4 b) { u32x4 o; o.x = pk2(a[0], a[1]); o.y = pk2(a[2], a[3]); o.z = pk2(b[0], b[1]); o.w = pk2(b[2], b[3]); return o; }

struct Epi1 {
    unsigned char* ws; int rowbase;
    __device__ __forceinline__ void operator()(f32x4 (&acc)[2][2][4][2], const Unit& u, int wr, int wc, int fr, int fq) const {
        bf16_t* KK = (bf16_t*)(ws + WS_KK); float* BB = (float*)(ws + WS_BB); const float* RS = (const float*)(ws + WS_RS); const float* LB = (const float*)(ws + WS_LB);
        const int type = u.pn >> 2, cs = (u.pn & 3) * 256 + wc * 32 + fq * 8;
        int lrow0 = u.pm * 256 + wr * 64 + fr; asm volatile("" : "+v"(lrow0));
#pragma unroll
        for (int ai = 0; ai < 2; ++ai)
#pragma unroll
            for (int m = 0; m < 4; ++m) { const float rs = RS[rowbase + lrow0 + ai * 128 + m * 16];
#pragma unroll
                for (int bj = 0; bj < 2; ++bj)
#pragma unroll
                    for (int n = 0; n < 2; ++n) acc[ai][bj][m][n] *= rs; }
        if (type != 1) {
            bf16_t* O = (bf16_t*)(ws + WS_QH + (size_t)(type == 0 ? 0 : (type == 2 ? 66 : 99)) * MiB);
#pragma unroll
            for (int ai = 0; ai < 2; ++ai)
#pragma unroll
                for (int m = 0; m < 4; ++m) { bf16_t* rowp = O + (size_t)(lrow0 + ai * 128 + m * 16) * D + cs;
#pragma unroll
                    for (int bj = 0; bj < 2; ++bj) { f32x4 v0 = acc[ai][bj][m][0], v1 = acc[ai][bj][m][1];
                        if (type != 2) {
#pragma unroll
                            for (int j = 0; j < 4; ++j) { v0[j] = siluf(v0[j]); v1[j] = siluf(v1[j]); } }
                        *(u32x4*)(rowp + bj * 128) = pack8(v0, v1); } }
        } else {
            const bool smp = (rowbase + u.pm * 256) >= MP;
#pragma unroll
            for (int bj = 0; bj < 2; ++bj) {
                const f32x4 lb0 = *(const f32x4*)(LB + cs + bj * 128), lb1 = *(const f32x4*)(LB + cs + bj * 128 + 4);
#pragma unroll
                for (int ai = 0; ai < 2; ++ai)
#pragma unroll
                    for (int m = 0; m < 4; ++m) {
                        f32x4 k0, k1;
#pragma unroll
                        for (int j = 0; j < 4; ++j) {
                            { const float v = fminf(fmaxf(acc[ai][bj][m][0][j], -30.f), 30.f); const float kk = (1.f - lb0[j]) * frcp(1.f + __expf(v)); k0[j] = kk; acc[ai][bj][m][0][j] = __logf(1.f - kk); }
                            { const float v = fminf(fmaxf(acc[ai][bj][m][1][j], -30.f), 30.f); const float kk = (1.f - lb1[j]) * frcp(1.f + __expf(v)); k1[j] = kk; acc[ai][bj][m][1][j] = __logf(1.f - kk); }
                        }
                        *(u32x4*)(KK + (size_t)(lrow0 + ai * 128 + m * 16) * D + cs + bj * 128) = pack8(k0, k1);
                    }
            }
#pragma unroll
            for (int ai = 0; ai < 2; ++ai)
#pragma unroll
                for (int bj = 0; bj < 2; ++bj)
#pragma unroll
                    for (int n = 0; n < 2; ++n)
#pragma unroll
                        for (int j = 0; j < 4; ++j) {
                            float v[4], tot[4];
#pragma unroll
                            for (int m = 0; m < 4; ++m) { float x = acc[ai][bj][m][n][j];
#pragma unroll
                                for (int d = 1; d < 16; d <<= 1) { const float t = __shfl_up(x, d, 16); if (fr >= d) x += t; }
                                v[m] = x; tot[m] = __shfl(x, 15, 16); }
                            if (!smp) { v[1] += tot[0]; v[2] += tot[0] + tot[1]; v[3] += (tot[0] + tot[1]) + tot[2]; }
                            else { v[1] += tot[0]; v[3] += tot[2]; }
#pragma unroll
                            for (int m = 0; m < 4; ++m) acc[ai][bj][m][n][j] = v[m];
                        }
#pragma unroll
            for (int ai = 0; ai < 2; ++ai)
#pragma unroll
                for (int m = 0; m < 4; ++m) { float* rowp = BB + (size_t)(lrow0 + ai * 128 + m * 16) * D + cs;
#pragma unroll
                    for (int bj = 0; bj < 2; ++bj) { *(f32x4*)(rowp + bj * 128) = acc[ai][bj][m][0]; *(f32x4*)(rowp + bj * 128 + 4) = acc[ai][bj][m][1]; } }
        }
    }
};
struct Epi2 {
    unsigned char* ws;
    __device__ __forceinline__ void operator()(f32x4 (&acc)[2][2][4][2], const Unit& u, int wr, int wc, int fr, int fq) const {
        bf16_t* MIX = (bf16_t*)(ws + WS_MIX); float* SSQ = (float*)(ws + WS_SSQ); asm volatile("" : "+v"(fr));
#pragma unroll
        for (int ai = 0; ai < 2; ++ai)
#pragma unroll
            for (int m = 0; m < 4; ++m) { const int row = u.pm * 256 + ai * 128 + wr * 64 + m * 16 + fr; float ss = 0.f;
                bf16_t* rowp = MIX + (size_t)row * D + u.pn * 256 + wc * 32 + fq * 8;
#pragma unroll
                for (int bj = 0; bj < 2; ++bj) { const f32x4 v0 = acc[ai][bj][m][0], v1 = acc[ai][bj][m][1];
#pragma unroll
                    for (int j = 0; j < 4; ++j) ss += v0[j] * v0[j] + v1[j] * v1[j];
                    *(u32x4*)(rowp + bj * 128) = pack8(v0, v1); }
                ss += __shfl_xor(ss, 16); ss += __shfl_xor(ss, 32);
                if (fq == 0) SSQ[(size_t)row * 16 + u.pn * 4 + wc] = ss; }
    }
};
struct Epi3 {
    unsigned char* ws;
    __device__ __forceinline__ void operator()(f32x4 (&acc)[2][2][4][2], const Unit& u, int wr, int wc, int fr, int fq) const {
        bf16_t* H = (bf16_t*)(ws + WS_H); const float* RS = (const float*)(ws + WS_RS); asm volatile("" : "+v"(fr));
#pragma unroll
        for (int ai = 0; ai < 2; ++ai)
#pragma unroll
            for (int m = 0; m < 4; ++m) { const int row = u.pm * 256 + ai * 128 + wr * 64 + m * 16 + fr; const float rs = RS[row];
                f32x4 h0, h1;
#pragma unroll
                for (int j = 0; j < 4; ++j) { h0[j] = siluf(acc[ai][0][m][0][j] * rs) * (acc[ai][1][m][0][j] * rs); h1[j] = siluf(acc[ai][0][m][1][j] * rs) * (acc[ai][1][m][1][j] * rs); }
                *(u32x4*)(H + (size_t)row * DFF + u.pn * 128 + wc * 32 + fq * 8) = pack8(h0, h1); }
    }
};
struct Epi5 {
    unsigned char* ws; float* out;
    __device__ __forceinline__ void operator()(f32x4 (&acc)[2][2][4][2], const Unit& u, int wr, int wc, int fr, int fq) const {
        bf16_t* Qb = (bf16_t*)(ws + WS_QB); const float* RS = (const float*)(ws + WS_RS); const float* ROPE = (const float*)(ws + WS_ROPE); asm volatile("" : "+v"(fr));
        const int d1 = fq * 8;
#pragma unroll
        for (int ai = 0; ai < 2; ++ai)
#pragma unroll
            for (int m = 0; m < 4; ++m) { const int row = u.pm * 256 + ai * 128 + wr * 64 + m * 16 + fr; const float rs = RS[row];
                int pos, crow, cb; bool smp = row >= MP;
                if (!smp) { const int t = row & (TP - 1); pos = t; cb = row >> 13; crow = t - (TP - 128); }
                else { const int lr = row - MP; const int t = lr & 31; pos = 2048 + t; cb = lr >> 5; crow = 96 + t; }
                f32x4 x1a = acc[ai][0][m][0] * rs, x1b = acc[ai][0][m][1] * rs, x2a = acc[ai][1][m][0] * rs, x2b = acc[ai][1][m][1] * rs;
                if (u.pn != 1) {
                    const f32x4* rp = (const f32x4*)(ROPE + ((size_t)pos * 32 + d1) * 2);
                    const f32x4 r0 = rp[0], r1 = rp[1], r2 = rp[2], r3 = rp[3];
                    f32x4 ca = {r0[0], r0[2], r1[0], r1[2]}, sa = {r0[1], r0[3], r1[1], r1[3]}, cb4 = {r2[0], r2[2], r3[0], r3[2]}, sb4 = {r2[1], r2[3], r3[1], r3[3]};
                    const f32x4 o1a = x1a * ca - x2a * sa, o2a = x2a * ca + x1a * sa, o1b = x1b * cb4 - x2b * sb4, o2b = x2b * cb4 + x1b * sb4;
                    x1a = o1a; x2a = o2a; x1b = o1b; x2b = o2b;
                }
                if (u.pn >= 2) {
                    const int hq = (u.pn - 2) * 4 + wc; bf16_t* q = Qb + (size_t)row * D + hq * 64 + d1;
                    *(u32x4*)q = pack8(x1a * 0.125f, x1b * 0.125f); *(u32x4*)(q + 32) = pack8(x2a * 0.125f, x2b * 0.125f);
                } else {
                    bf16_t* kb = (bf16_t*)(ws + WS_KB + (size_t)(u.pn == 0 ? 0 : 17) * MiB) + (size_t)row * 256 + wc * 64 + d1;
                    *(u32x4*)kb = pack8(x1a, x1b); *(u32x4*)(kb + 32) = pack8(x2a, x2b);
                    if (crow >= 0) {
                        float* co = out + (smp ? (u.pn == 0 ? OUT_CKS : OUT_CVS) : (u.pn == 0 ? OUT_CKP : OUT_CVP)) + ((size_t)(cb * 128 + crow) * 4 + wc) * 64 + d1;
                        *(f32x4*)co = x1a; *(f32x4*)(co + 4) = x1b; *(f32x4*)(co + 32) = x2a; *(f32x4*)(co + 36) = x2b;
                    }
                }
            }
    }
};

__device__ __forceinline__ void tr_item(const float* W, int ldw, int col0, const float* fold, bf16_t* WT, int K, int drow0, int k0, LAS float* scr, int lane) {
#pragma unroll 8
    for (int i = 0; i < 32; ++i) { const int kk = 2 * i + (lane >> 5); float w = W[(size_t)(k0 + kk) * ldw + col0 + (lane & 31)]; if (fold) w *= fold[k0 + kk]; scr[kk * 33 + (lane & 31)] = w; }
    LDS_WAIT();
    const int c = lane & 7;
#pragma unroll
    for (int j = 0; j < 4; ++j) { const int n = (lane >> 3) + 8 * j; const LAS float* s = scr + (8 * c) * 33 + n;
        u32x4 o; o.x = pk2(s[0 * 33], s[1 * 33]); o.y = pk2(s[2 * 33], s[3 * 33]); o.z = pk2(s[4 * 33], s[5 * 33]); o.w = pk2(s[6 * 33], s[7 * 33]);
        *(u32x4*)(WT + (size_t)(drow0 + n) * K + k0 + 8 * c) = o; }
    LDS_WAIT();
}
__device__ __forceinline__ const float* xrow_ptr(KP p, int row) { return row < MP ? p->in[0] + (size_t)row * D : p->in[1] + (size_t)(row - MP) * D; }

__device__ __forceinline__ void p0_prologue(LAS unsigned char* lds, KP p) {
    const int tid = o_tid(), lane = tid & 63, wave = tid >> 6;
    LAS float* scr = (LAS float*)(lds + wave * 16384);
    const int bidx = o_bid(), gdim = o_grid();
    const int gw = bidx * 8 + wave, NGW = gdim * 8;
    unsigned char* ws = p->ws;
    constexpr int I1 = 16 * 128, I2 = 16 * 32, I3 = 16 * 176, I4 = 44 * 32, I5 = 16 * 48, I6 = 16 * 32, I7 = I3, I8 = I4;
    constexpr int NIT = I1 + I2 + I3 + I4 + I5 + I6 + I7 + I8;
    for (int it = gw; it < NIT; it += NGW) {
        int r = it;
        if (r < I1) { const int nb = r % 128, kb = r / 128; tr_item(p->in[11], 4096, 32 * nb, p->in[5], (bf16_t*)(ws + WS_W1), 1024, 32 * nb, 64 * kb, scr, lane); continue; } r -= I1;
        if (r < I2) { const int nb = r % 32, kb = r / 32; tr_item(p->in[14], 1024, 32 * nb, nullptr, (bf16_t*)(ws + WS_W2), 1024, 32 * nb, 64 * kb, scr, lane); continue; } r -= I2;
        if (r < I3) { const int nb = r % 176, kb = r / 176; const int rho = 32 * nb, col = ((rho >> 7) & 1) * DFF + 128 * (rho >> 8) + (rho & 127);
            tr_item(p->in[9], 2 * DFF, col, p->in[7], (bf16_t*)(ws + WS_W3), 1024, rho, 64 * kb, scr, lane); continue; } r -= I3;
        if (r < I4) { const int nb = r % 32, kb = r / 32; tr_item(p->in[10], 1024, 32 * nb, nullptr, (bf16_t*)(ws + WS_W4), DFF, 32 * nb, 64 * kb, scr, lane); continue; } r -= I4;
        if (r < I5) { const int nb = r % 48, kb = r / 48; const int rho = 32 * nb, cc = 256 * (rho >> 8) + 64 * ((rho & 127) >> 5) + 32 * ((rho >> 7) & 1);
            if (cc < 512) tr_item(p->in[16], 512, cc, p->in[15], (bf16_t*)(ws + WS_W5), 1024, rho, 64 * kb, scr, lane);
            else tr_item(p->in[17], 1024, cc - 512, p->in[5] + D, (bf16_t*)(ws + WS_W5), 1024, rho, 64 * kb, scr, lane);
            continue; } r -= I5;
        if (r < I6) { const int nb = r % 32, kb = r / 32; tr_item(p->in[19], 1024, 32 * nb, nullptr, (bf16_t*)(ws + WS_W6), 1024, 32 * nb, 64 * kb, scr, lane); continue; } r -= I6;
        if (r < I7) { const int nb = r % 176, kb = r / 176; const int rho = 32 * nb, col = ((rho >> 7) & 1) * DFF + 128 * (rho >> 8) + (rho & 127);
            tr_item(p->in[9] + (size_t)D * 2 * DFF, 2 * DFF, col, p->in[7] + D, (bf16_t*)(ws + WS_W7), 1024, rho, 64 * kb, scr, lane); continue; } r -= I7;
        { const int nb = r % 32, kb = r / 32; tr_item(p->in[10] + (size_t)DFF * D, 1024, 32 * nb, nullptr, (bf16_t*)(ws + WS_W8), DFF, 32 * nb, 64 * kb, scr, lane); }
    }
    bf16_t* XB = (bf16_t*)(ws + WS_XB); float* RS = (float*)(ws + WS_RS);
    for (int row = gw; row < MT; row += NGW) {
        const f32x4* xr = (const f32x4*)xrow_ptr(p, row) + lane; float s = 0.f; f32x4 v[4];
#pragma unroll
        for (int j = 0; j < 4; ++j) { v[j] = xr[64 * j]; s += (v[j][0] * v[j][0] + v[j][1] * v[j][1]) + (v[j][2] * v[j][2] + v[j][3] * v[j][3]); }
        s = wave_sum(s);
        u32x2* o = (u32x2*)(XB + (size_t)row * D) + lane;
#pragma unroll
        for (int j = 0; j < 4; ++j) { u32x2 w; w.x = pk2(v[j][0], v[j][1]); w.y = pk2(v[j][2], v[j][3]); o[64 * j] = w; }
        if (lane == 0) RS[row] = rsqrtf(s * (1.f / D) + EPS);
    }
    const int gt = bidx * 512 + tid, NGT = gdim * 512;
    float* ROPE = (float*)(ws + WS_ROPE);
    for (int i = gt; i < TP * 32; i += NGT) { const int pos = i >> 5, d = i & 31;
        const float inv = exp2f(-(float)d * (13.287712379549449f / 32.f));
        const float ang = (float)pos * inv;
        double rev = (double)ang * 0.15915494309189535; rev -= __builtin_rint(rev);
        const float rr = (float)rev;
        ROPE[2 * i] = __builtin_amdgcn_cosf(rr); ROPE[2 * i + 1] = __builtin_amdgcn_sinf(rr); }
    float* LB = (float*)(ws + WS_LB);
    for (int i = gt; i < D; i += NGT) { const float a0 = p->in[12][i], a1 = p->in[12][D + i]; LB[i] = 1.f / (1.f + expf(a1 - a0)); }
    for (int i = gt; i < 16 * 96 * 64; i += NGT) { const int b = i / (96 * 64), rem = i % (96 * 64);
        const f32x4 kv = *((const f32x4*)(p->in[3] + (size_t)b * 32768 + 32 * 256) + rem), vv = *((const f32x4*)(p->in[4] + (size_t)b * 32768 + 32 * 256) + rem);
        *((f32x4*)(p->out + OUT_CKS + (size_t)b * 32768) + rem) = kv; *((f32x4*)(p->out + OUT_CVS + (size_t)b * 32768) + rem) = vv; }
}

__device__ __forceinline__ f32x16 mfma32(bf16x8 a, bf16x8 b, f32x16 c) { return __builtin_amdgcn_mfma_f32_32x32x16_bf16(a, b, c, 0, 0, 0); }
__device__ __forceinline__ f32x16 zero16() { f32x16 z; for (int i = 0; i < 16; ++i) z[i] = 0.f; return z; }

struct HUnit { int row0, L, h, sb; };
__device__ __forceinline__ HUnit hunit(int u, int hf) { HUnit r;
    if (u < 2048) { r.row0 = (2 * hf + (u >> 10)) * TP + 64 * ((u >> 3) & 127); r.L = 64; r.h = u & 7; r.sb = -1; }
    else { const int uu = u - 2048; r.sb = uu >> 3; r.h = uu & 7; r.row0 = MP + 32 * r.sb; r.L = 32; }
    return r; }

__device__ __forceinline__ void h1_phase(LAS unsigned char* lds, KP p, int hf) {
    const int tid = o_tid(), lane = tid & 63, w = tid >> 6, r32 = lane & 31, hh = lane >> 5;
    LAS bf16_t* KT = (LAS bf16_t*)lds; LAS bf16_t* VT = KT + 128 * 72;
    const int nunits = hf ? 2176 : 2048, rowbase = hf ? 16384 : 0;
    const float* BB = (const float*)(p->ws + WS_BB); const bf16_t* KK = (const bf16_t*)(p->ws + WS_KK); const bf16_t* VV = (const bf16_t*)(p->ws + WS_VV);
    bf16_t* ST = (bf16_t*)(p->ws + WS_ST);
    const int r = tid >> 3, c16 = (tid & 7) * 16;
    const int bidx = o_bid(), gdim = o_grid();
    for (int u = bidx; u < nunits; u += gdim) {
        const HUnit hu = hunit(u, hf); const int lrow0 = hu.row0 - rowbase;
        const size_t off = (size_t)(lrow0 + r) * D + hu.h * 128 + c16, offl = (size_t)(lrow0 + hu.L - 1) * D + hu.h * 128 + c16;
        const bool valid = r < hu.L;
#pragma unroll
        for (int q = 0; q < 2; ++q) {
            u32x4 kq = {0u, 0u, 0u, 0u}, vq = {0u, 0u, 0u, 0u}; f32x4 b0 = {0, 0, 0, 0}, b1 = b0, l0 = b0, l1 = b0;
            if (valid) { kq = *(const u32x4*)(KK + off + 8 * q); vq = *(const u32x4*)(VV + off + 8 * q);
                b0 = *(const f32x4*)(BB + off + 8 * q); b1 = *(const f32x4*)(BB + off + 8 * q + 4); l0 = *(const f32x4*)(BB + offl + 8 * q); l1 = *(const f32x4*)(BB + offl + 8 * q + 4); }
            float kt[8];
            kt[0] = bflo(kq.x) * __expf(l0[0] - b0[0]); kt[1] = bfhi(kq.x) * __expf(l0[1] - b0[1]); kt[2] = bflo(kq.y) * __expf(l0[2] - b0[2]); kt[3] = bfhi(kq.y) * __expf(l0[3] - b0[3]);
            kt[4] = bflo(kq.z) * __expf(l1[0] - b1[0]); kt[5] = bfhi(kq.z) * __expf(l1[1] - b1[1]); kt[6] = bflo(kq.w) * __expf(l1[2] - b1[2]); kt[7] = bfhi(kq.w) * __expf(l1[3] - b1[3]);
            const unsigned vw[4] = {vq.x, vq.y, vq.z, vq.w};
#pragma unroll
            for (int i = 0; i < 4; ++i) { const unsigned pk = pk2(kt[2 * i], kt[2 * i + 1]); const int cc = c16 + 8 * q + 2 * i;
                KT[cc * 72 + r] = (bf16_t)(pk & 0xffffu); KT[(cc + 1) * 72 + r] = (bf16_t)(pk >> 16);
                VT[cc * 72 + r] = (bf16_t)(vw[i] & 0xffffu); VT[(cc + 1) * 72 + r] = (bf16_t)(vw[i] >> 16); }
        }
        __syncthreads();
        const int dvt = w >> 1, dk0 = (w & 1) * 2;
        f32x16 acc0 = zero16(), acc1 = zero16();
#pragma unroll
        for (int ks = 0; ks < 4; ++ks) {
            const bf16x8 a = *(const LAS bf16x8*)(VT + (dvt * 32 + r32) * 72 + ks * 16 + hh * 8);
            const bf16x8 bq0 = *(const LAS bf16x8*)(KT + (dk0 * 32 + r32) * 72 + ks * 16 + hh * 8);
            const bf16x8 bq1 = *(const LAS bf16x8*)(KT + ((dk0 + 1) * 32 + r32) * 72 + ks * 16 + hh * 8);
            acc0 = mfma32(a, bq0, acc0); acc1 = mfma32(a, bq1, acc1);
        }
        bf16_t* st = ST + (size_t)u * 16384;
        if (hu.L == 64) {
#pragma unroll
            for (int reg = 0; reg < 16; ++reg) { const int dv = dvt * 32 + (reg & 3) + 8 * (reg >> 2) + 4 * hh;
                st[dv * 128 + dk0 * 32 + r32] = (bf16_t)(pk2(acc0[reg], 0.f) & 0xffffu); st[dv * 128 + (dk0 + 1) * 32 + r32] = (bf16_t)(pk2(acc1[reg], 0.f) & 0xffffu); }
        } else {
            const float* s0p = p->in[2] + (size_t)(hu.sb * 8 + hu.h) * 16384; float* sop = p->out + OUT_STS + (size_t)(hu.sb * 8 + hu.h) * 16384;
            const float* bl = BB + (size_t)(lrow0 + 31) * D + hu.h * 128;
#pragma unroll
            for (int jt = 0; jt < 2; ++jt) { const int dk = (dk0 + jt) * 32 + r32; const float dec = __expf(bl[dk]);
#pragma unroll
                for (int reg = 0; reg < 16; ++reg) { const int dv = dvt * 32 + (reg & 3) + 8 * (reg >> 2) + 4 * hh;
                    const float s0 = s0p[dk * 128 + dv]; const float a = jt ? acc1[reg] : acc0[reg];
                    sop[dk * 128 + dv] = dec * s0 + a; st[dv * 128 + dk] = (bf16_t)(pk2(s0, 0.f) & 0xffffu); } }
        }
        __syncthreads();
    }
}
__device__ __forceinline__ void h2_phase(KP p, int hf) {
    const int tid = o_tid(); const int bidx = o_bid(), gdim = o_grid();
    const float* BB = (const float*)(p->ws + WS_BB); unsigned* ST = (unsigned*)(p->ws + WS_ST);
    for (int it = bidx * 512 + tid; it < 16 * 8192; it += gdim * 512) {
        const int pair = it >> 13, e = it & 8191, dv = e >> 6, dk = (e & 63) * 2, bl = pair >> 3, h = pair & 7;
        float s0 = 0.f, s1 = 0.f;
        unsigned* sp = ST + ((size_t)(bl * 1024 + h) * 16384 + dv * 128 + dk) / 2;
        const float* bp = BB + (size_t)(bl * TP + 63) * D + h * 128 + dk;
        for (int c0 = 0; c0 < 128; c0 += 8) {
            unsigned uu[8]; f32x2 dd[8];
#pragma unroll
            for (int i = 0; i < 8; ++i) { uu[i] = sp[(size_t)(c0 + i) * 65536]; dd[i] = *(const f32x2*)(bp + (size_t)(c0 + i) * 64 * D); }
#pragma unroll
            for (int i = 0; i < 8; ++i) { sp[(size_t)(c0 + i) * 65536] = pk2(s0, s1); s0 = __expf(dd[i][0]) * s0 + bflo(uu[i]); s1 = __expf(dd[i][1]) * s1 + bfhi(uu[i]); }
        }
        float* so = p->out + OUT_STP + (size_t)((2 * hf + bl) * 8 + h) * 16384;
        so[dk * 128 + dv] = s0; so[(dk + 1) * 128 + dv] = s1;
    }
}
__device__ __forceinline__ void h3_phase(LAS unsigned char* lds, KP p, int hf) {
    const int tid = o_tid(), lane = tid & 63, w = tid >> 6, r32 = lane & 31, hh = lane >> 5;
    LAS bf16_t* Qs = (LAS bf16_t*)lds; LAS bf16_t* Ks = Qs + 64 * 136; LAS bf16_t* VT = Ks + 64 * 136; LAS bf16_t* Ss = VT + 128 * 72; LAS float* red = (LAS float*)(Ss + 128 * 136);
    const int nunits = hf ? 2176 : 2048, rowbase = hf ? 16384 : 0;
    const float* BB = (const float*)(p->ws + WS_BB); const bf16_t* KK = (const bf16_t*)(p->ws + WS_KK); const bf16_t* VV = (const bf16_t*)(p->ws + WS_VV);
    const bf16_t* QH = (const bf16_t*)(p->ws + WS_QH); const bf16_t* GG = (const bf16_t*)(p->ws + WS_GG);
    const bf16_t* ST = (const bf16_t*)(p->ws + WS_ST); bf16_t* O2 = (bf16_t*)(p->ws + WS_XB);
    const float* gnorm = p->in[13];
    const int r = tid >> 3, c16 = (tid & 7) * 16;
    const int bidx = o_bid(), gdim = o_grid();
    for (int u = bidx; u < nunits; u += gdim) {
        const HUnit hu = hunit(u, hf); const int lrow0 = hu.row0 - rowbase;
        const size_t off = (size_t)(lrow0 + r) * D + hu.h * 128 + c16;
        const bool valid = r < hu.L;
#pragma unroll
        for (int q = 0; q < 2; ++q) {
            u32x4 kq = {0u, 0u, 0u, 0u}, vq = kq, qq = kq; f32x4 b0 = {0, 0, 0, 0}, b1 = b0;
            if (valid) { kq = *(const u32x4*)(KK + off + 8 * q); vq = *(const u32x4*)(VV + off + 8 * q); qq = *(const u32x4*)(QH + off + 8 * q);
                b0 = *(const f32x4*)(BB + off + 8 * q); b1 = *(const f32x4*)(BB + off + 8 * q + 4); }
            float eb[8], kf[8], qf[8];
#pragma unroll
            for (int j = 0; j < 4; ++j) { eb[j] = __expf(b0[j]); eb[4 + j] = __expf(b1[j]); }
            kf[0] = bflo(kq.x); kf[1] = bfhi(kq.x); kf[2] = bflo(kq.y); kf[3] = bfhi(kq.y); kf[4] = bflo(kq.z); kf[5] = bfhi(kq.z); kf[6] = bflo(kq.w); kf[7] = bfhi(kq.w);
            qf[0] = bflo(qq.x); qf[1] = bfhi(qq.x); qf[2] = bflo(qq.y); qf[3] = bfhi(qq.y); qf[4] = bflo(qq.z); qf[5] = bfhi(qq.z); qf[6] = bflo(qq.w); qf[7] = bfhi(qq.w);
            u32x4 qo, ko;
            qo.x = pk2(qf[0] * eb[0], qf[1] * eb[1]); qo.y = pk2(qf[2] * eb[2], qf[3] * eb[3]); qo.z = pk2(qf[4] * eb[4], qf[5] * eb[5]); qo.w = pk2(qf[6] * eb[6], qf[7] * eb[7]);
            ko.x = pk2(kf[0] * frcp(eb[0]), kf[1] * frcp(eb[1])); ko.y = pk2(kf[2] * frcp(eb[2]), kf[3] * frcp(eb[3])); ko.z = pk2(kf[4] * frcp(eb[4]), kf[5] * frcp(eb[5])); ko.w = pk2(kf[6] * frcp(eb[6]), kf[7] * frcp(eb[7]));
            *(LAS u32x4*)(Qs + r * 136 + c16 + 8 * q) = qo; *(LAS u32x4*)(Ks + r * 136 + c16 + 8 * q) = ko;
            const unsigned vw[4] = {vq.x, vq.y, vq.z, vq.w};
#pragma unroll
            for (int i = 0; i < 4; ++i) { const int cc = c16 + 8 * q + 2 * i; VT[cc * 72 + r] = (bf16_t)(vw[i] & 0xffffu); VT[(cc + 1) * 72 + r] = (bf16_t)(vw[i] >> 16); }
        }
        { const u32x4* sp = (const u32x4*)(ST + (size_t)u * 16384);
#pragma unroll
            for (int i = 0; i < 4; ++i) { const int idx = tid + 512 * i; *(LAS u32x4*)(Ss + (idx >> 4) * 136 + (idx & 15) * 8) = sp[idx]; } }
        __syncthreads();
        const int tt = w & 1, dvt = w >> 1;
        f32x16 o = zero16();
#pragma unroll
        for (int ks = 0; ks < 8; ++ks) {
            const bf16x8 a = *(const LAS bf16x8*)(Ss + (dvt * 32 + r32) * 136 + ks * 16 + hh * 8);
            const bf16x8 b = *(const LAS bf16x8*)(Qs + (tt * 32 + r32) * 136 + ks * 16 + hh * 8);
            o = mfma32(a, b, o);
        }
#pragma unroll
        for (int st = 0; st < 2; ++st) {
            if (st <= tt) {
                f32x16 pp = zero16();
#pragma unroll
                for (int ks = 0; ks < 8; ++ks) {
                    const bf16x8 a = *(const LAS bf16x8*)(Ks + (st * 32 + r32) * 136 + ks * 16 + hh * 8);
                    const bf16x8 b = *(const LAS bf16x8*)(Qs + (tt * 32 + r32) * 136 + ks * 16 + hh * 8);
                    pp = mfma32(a, b, pp);
                }
                if (st == tt) {
#pragma unroll
                    for (int reg = 0; reg < 16; ++reg) { const int sl = (reg & 3) + 8 * (reg >> 2) + 4 * hh; if (sl > r32) pp[reg] = 0.f; }
                }
#pragma unroll
                for (int s2 = 0; s2 < 2; ++s2) {
                    u32x4 pb; pb.x = pk2(pp[8 * s2 + 0], pp[8 * s2 + 1]); pb.y = pk2(pp[8 * s2 + 2], pp[8 * s2 + 3]); pb.z = pk2(pp[8 * s2 + 4], pp[8 * s2 + 5]); pb.w = pk2(pp[8 * s2 + 6], pp[8 * s2 + 7]);
                    const LAS bf16_t* vp = VT + (dvt * 32 + r32) * 72 + st * 32 + 16 * s2 + 4 * hh;
                    const u32x2 va = *(const LAS u32x2*)vp, vb = *(const LAS u32x2*)(vp + 8);
                    u32x4 av; av.x = va.x; av.y = va.y; av.z = vb.x; av.w = vb.y;
                    o = mfma32(__builtin_bit_cast(bf16x8, av), __builtin_bit_cast(bf16x8, pb), o);
                }
            }
        }
        float ss = 0.f;
#pragma unroll
        for (int reg = 0; reg < 16; ++reg) ss += o[reg] * o[reg];
        ss += __shfl_xor(ss, 32);
        if (hh == 0) red[(tt * 32 + r32) * 4 + dvt] = ss;
        __syncthreads();
        { const int t = tt * 32 + r32; const f32x4 rr = *(const LAS f32x4*)(red + t * 4); const float rsn = rsqrtf(((rr[0] + rr[1]) + (rr[2] + rr[3])) * (1.f / 128.f) + EPS);
            if (t < hu.L) {
                const bf16_t* gp = GG + (size_t)(lrow0 + t) * D + hu.h * 128; bf16_t* op = O2 + (size_t)(hu.row0 + t) * D + hu.h * 128;
#pragma unroll
                for (int g4 = 0; g4 < 4; ++g4) { const int dv = dvt * 32 + 8 * g4 + 4 * hh;
                    const u32x2 gv = *(const u32x2*)(gp + dv); const f32x4 gw = *(const f32x4*)(gnorm + hu.h * 128 + dv);
                    u32x2 ov; ov.x = pk2(o[4 * g4 + 0] * rsn * gw[0] * bflo(gv.x), o[4 * g4 + 1] * rsn * gw[1] * bfhi(gv.x));
                    ov.y = pk2(o[4 * g4 + 2] * rsn * gw[2] * bflo(gv.y), o[4 * g4 + 3] * rsn * gw[3] * bfhi(gv.y));
                    *(u32x2*)(op + dv) = ov; }
            } }
        __syncthreads();
    }
}

__device__ __forceinline__ void attn_phase(LAS unsigned char* lds, KP p) {
    const int tid = o_tid(), lane = tid & 63, w = tid >> 6, r32 = lane & 31, hh = lane >> 5;
    LAS bf16_t* Ks = (LAS bf16_t*)lds; LAS bf16_t* VT = Ks + 192 * 72;
    const bf16_t* Kb = (const bf16_t*)(p->ws + WS_KB); const bf16_t* Vb = (const bf16_t*)(p->ws + WS_VB); const bf16_t* Qb = (const bf16_t*)(p->ws + WS_QB);
    bf16_t* O = (bf16_t*)(p->ws + WS_XB);
    const float* sinks = p->in[18];
    const int bidx = o_bid(), gdim = o_grid();
    for (int u = bidx; u < 2048 + 64; u += gdim) {
        int qrow0, krow0, nk, kvh, L, sb = -1;
        if (u < 2048) { const int b = u >> 9, c = (u >> 2) & 127; kvh = u & 3; const int c0 = c < 2 ? 0 : c - 2; qrow0 = b * TP + 64 * c; krow0 = b * TP + 64 * c0; nk = (c - c0 + 1) * 64; L = 64; }
        else { const int uu = u - 2048; sb = uu >> 2; kvh = uu & 3; qrow0 = MP + 32 * sb; krow0 = qrow0 - 128; nk = 160; L = 32; }
        for (int idx = tid; idx < nk * 8; idx += 512) { const int s = idx >> 3, p8 = (idx & 7) * 8;
            u32x4 kq, vq;
            if (sb >= 0 && s < 128) { const float* kp = p->in[3] + ((size_t)(sb * 128 + s) * 4 + kvh) * 64 + p8; const float* vp = p->in[4] + ((size_t)(sb * 128 + s) * 4 + kvh) * 64 + p8;
                kq = pack8(*(const f32x4*)kp, *(const f32x4*)(kp + 4)); vq = pack8(*(const f32x4*)vp, *(const f32x4*)(vp + 4)); }
            else { kq = *(const u32x4*)(Kb + (size_t)(krow0 + s) * 256 + kvh * 64 + p8); vq = *(const u32x4*)(Vb + (size_t)(krow0 + s) * 256 + kvh * 64 + p8); }
            *(LAS u32x4*)(Ks + s * 72 + p8) = kq;
            const unsigned vw[4] = {vq.x, vq.y, vq.z, vq.w};
#pragma unroll
            for (int i = 0; i < 4; ++i) { VT[(p8 + 2 * i) * 200 + s] = (bf16_t)(vw[i] & 0xffffu); VT[(p8 + 2 * i + 1) * 200 + s] = (bf16_t)(vw[i] >> 16); }
        }
        __syncthreads();
        const int g = w >> 1, tt = w & 1, qh = kvh * 4 + g, nst = nk >> 5;
        if (tt * 32 < L) {
            const int t = tt * 32 + r32;
            bf16x8 qf[4];
#pragma unroll
            for (int ks = 0; ks < 4; ++ks) qf[ks] = *(const bf16x8*)(Qb + (size_t)(qrow0 + t) * D + qh * 64 + ks * 16 + hh * 8);
            f32x16 pp[6];
            const float sink = sinks[qh];
            float mx = sink;
#pragma unroll
            for (int st = 0; st < 6; ++st) {
                pp[st] = zero16();
                if (st < nst) {
#pragma unroll
                    for (int ks = 0; ks < 4; ++ks) pp[st] = mfma32(*(const LAS bf16x8*)(Ks + (st * 32 + r32) * 72 + ks * 16 + hh * 8), qf[ks], pp[st]);
#pragma unroll
                    for (int reg = 0; reg < 16; ++reg) mx = fmaxf(mx, pp[st][reg]);
                }
            }
            mx = fmaxf(mx, __shfl_xor(mx, 32));
            float sum = 0.f;
#pragma unroll
            for (int st = 0; st < 6; ++st) if (st < nst) {
#pragma unroll
                for (int reg = 0; reg < 16; ++reg) { const float e = __expf(pp[st][reg] - mx); pp[st][reg] = e; sum += e; } }
            sum += __shfl_xor(sum, 32);
            const float inv = frcp(sum + __expf(sink - mx));
            f32x16 o0 = zero16(), o1 = zero16();
#pragma unroll
            for (int st = 0; st < 6; ++st) if (st < nst) {
#pragma unroll
                for (int s2 = 0; s2 < 2; ++s2) {
                    u32x4 pb; pb.x = pk2(pp[st][8 * s2 + 0], pp[st][8 * s2 + 1]); pb.y = pk2(pp[st][8 * s2 + 2], pp[st][8 * s2 + 3]); pb.z = pk2(pp[st][8 * s2 + 4], pp[st][8 * s2 + 5]); pb.w = pk2(pp[st][8 * s2 + 6], pp[st][8 * s2 + 7]);
                    const bf16x8 pbv = __builtin_bit_cast(bf16x8, pb);
                    { const LAS bf16_t* vp = VT + r32 * 200 + st * 32 + 16 * s2 + 4 * hh; const u32x2 va = *(const LAS u32x2*)vp, vb = *(const LAS u32x2*)(vp + 8);
                      u32x4 av; av.x = va.x; av.y = va.y; av.z = vb.x; av.w = vb.y; o0 = mfma32(__builtin_bit_cast(bf16x8, av), pbv, o0); }
                    { const LAS bf16_t* vp = VT + (32 + r32) * 200 + st * 32 + 16 * s2 + 4 * hh; const u32x2 va = *(const LAS u32x2*)vp, vb = *(const LAS u32x2*)(vp + 8);
                      u32x4 av; av.x = va.x; av.y = va.y; av.z = vb.x; av.w = vb.y; o1 = mfma32(__builtin_bit_cast(bf16x8, av), pbv, o1); }
                }
            }
            bf16_t* op = O + (size_t)(qrow0 + t) * D + qh * 64;
#pragma unroll
            for (int g4 = 0; g4 < 4; ++g4) { const int dv = 8 * g4 + 4 * hh;
                u32x2 a; a.x = pk2(o0[4 * g4] * inv, o0[4 * g4 + 1] * inv); a.y = pk2(o0[4 * g4 + 2] * inv, o0[4 * g4 + 3] * inv); *(u32x2*)(op + dv) = a;
                u32x2 b; b.x = pk2(o1[4 * g4] * inv, o1[4 * g4 + 1] * inv); b.y = pk2(o1[4 * g4 + 2] * inv, o1[4 * g4 + 3] * inv); *(u32x2*)(op + 32 + dv) = b; }
        }
        __syncthreads();
    }
}

template <int MODE, bool LAST>
__device__ __forceinline__ void x_phase(KP p, const float* wpost) {
    const int tid = o_tid(), lane = tid & 63, wave = tid >> 6;
    const int gw = o_bid() * 8 + wave, NGW = o_grid() * 8;
    const bf16_t* MIX = (const bf16_t*)(p->ws + WS_MIX); const float* SSQ = (const float*)(p->ws + WS_SSQ);
    float* XR = (float*)(p->ws + WS_XR); bf16_t* XB = (bf16_t*)(p->ws + WS_XB); float* RS = (float*)(p->ws + WS_RS);
    f32x4 wv[4];
#pragma unroll
    for (int j = 0; j < 4; ++j) wv[j] = *((const f32x4*)wpost + lane + 64 * j);
    for (int row = gw; row < MT; row += NGW) {
        const f32x4* sq = (const f32x4*)(SSQ + (size_t)row * 16); const f32x4 s0 = sq[0], s1 = sq[1], s2 = sq[2], s3 = sq[3];
        const float tot = (((s0[0] + s0[1]) + (s0[2] + s0[3])) + ((s1[0] + s1[1]) + (s1[2] + s1[3]))) + (((s2[0] + s2[1]) + (s2[2] + s2[3])) + ((s3[0] + s3[1]) + (s3[2] + s3[3])));
        const float rsm = rsqrtf(tot * (1.f / D) + EPS);
        const f32x4* xr = (MODE == 0 ? (const f32x4*)xrow_ptr(p, row) : (const f32x4*)(XR + (size_t)row * D)) + lane;
        const u32x2* mr = (const u32x2*)(MIX + (size_t)row * D) + lane;
        f32x4 v[4]; float s = 0.f;
#pragma unroll
        for (int j = 0; j < 4; ++j) { const f32x4 x = xr[64 * j]; const u32x2 mm = mr[64 * j];
            v[j][0] = x[0] + bflo(mm.x) * rsm * wv[j][0]; v[j][1] = x[1] + bfhi(mm.x) * rsm * wv[j][1]; v[j][2] = x[2] + bflo(mm.y) * rsm * wv[j][2]; v[j][3] = x[3] + bfhi(mm.y) * rsm * wv[j][3];
            s += (v[j][0] * v[j][0] + v[j][1] * v[j][1]) + (v[j][2] * v[j][2] + v[j][3] * v[j][3]); }
        if (LAST) {
            f32x4* o = (f32x4*)(p->out + OUT_Y + (size_t)row * D) + lane;
#pragma unroll
            for (int j = 0; j < 4; ++j) o[64 * j] = v[j];
        } else {
            s = wave_sum(s);
            f32x4* o = (f32x4*)(XR + (size_t)row * D) + lane; u32x2* ob = (u32x2*)(XB + (size_t)row * D) + lane;
#pragma unroll
            for (int j = 0; j < 4; ++j) { o[64 * j] = v[j]; u32x2 wb; wb.x = pk2(v[j][0], v[j][1]); wb.y = pk2(v[j][2], v[j][3]); ob[64 * j] = wb; }
            if (lane == 0) RS[row] = rsqrtf(s * (1.f / D) + EPS);
        }
    }
}

constexpr int NPHASE = 21;
__global__ void __launch_bounds__(512, 2) mega(Params p_arg, int ph_lo, int ph_hi) {
    extern __shared__ __attribute__((aligned(16))) unsigned char lds_raw[];
    LAS unsigned char* lds = (LAS unsigned char*)lds_raw;
    cg::grid_group grid = cg::this_grid();
#define G o_grid()
#define bid o_bid()
#define p kparams()
#define ws (kparams()->ws)
#ifndef PHMASK
#define PHMASK 0x1fffff
#endif
#define IN(k) (((PHMASK >> (k)) & 1) && ph_lo <= (k) && (k) < ph_hi)
#define SEAM(k) do { if (IN((k) + 1)) grid.sync(); else __syncthreads(); } while (0)
    if (IN(0)) { p0_prologue(lds, p); SEAM(0); }
#pragma unroll 1
    for (int hf = 0; hf < 2; ++hf) {
        const int rowbase = hf ? 16384 : 0, rows = hf ? 16896 : 16384, pb = 1 + 4 * hf;
        if (IN(pb)) {
            pg8::Gemm g{(const bf16_t*)(ws + WS_XB) + (size_t)rowbase * D, (const bf16_t*)(ws + WS_W1), rows, 4096, 1024}; pg8::StaticOrder S; S.init(rows, 4096, G, bid);
            Epi1 E{ws, rowbase};
            pg8::gemm_phase<Epi1>(lds, g, S, E); SEAM(pb);
        }
        if (IN(pb + 1)) { h1_phase(lds, p, hf); SEAM(pb + 1); }
        if (IN(pb + 2)) { h2_phase(p, hf); SEAM(pb + 2); }
        if (IN(pb + 3)) { h3_phase(lds, p, hf); SEAM(pb + 3); }
    }
    if (IN(9)) {
        pg8::Gemm g{(const bf16_t*)(ws + WS_XB), (const bf16_t*)(ws + WS_W2), MT, 1024, 1024}; pg8::StaticOrder S; S.init(MT, 1024, G, bid);
        Epi2 E{ws}; pg8::gemm_phase<Epi2>(lds, g, S, E); SEAM(9);
    }
    if (IN(10)) { x_phase<0, false>(p, p->in[6]); SEAM(10); }
#pragma unroll 1
    for (int ly = 0; ly < 2; ++ly) {
        const int pb = ly ? 18 : 11;
        if (IN(pb)) {
            pg8::Gemm g{(const bf16_t*)(ws + WS_XB), (const bf16_t*)(ws + (ly ? WS_W7 : WS_W3)), MT, 2 * DFF, 1024}; pg8::StaticOrder S; S.init(MT, 2 * DFF, G, bid);
            Epi3 E{ws}; pg8::gemm_phase<Epi3>(lds, g, S, E); SEAM(pb);
        }
        if (IN(pb + 1)) {
            pg8::Gemm g{(const bf16_t*)(ws + WS_H), (const bf16_t*)(ws + (ly ? WS_W8 : WS_W4)), MT, 1024, DFF}; pg8::StaticOrder S; S.init(MT, 1024, G, bid);
            Epi2 E{ws}; pg8::gemm_phase<Epi2>(lds, g, S, E); SEAM(pb + 1);
        }
        if (ly == 0) {
            if (IN(13)) { x_phase<1, false>(p, p->in[8]); SEAM(13); }
            if (IN(14)) {
                pg8::Gemm g{(const bf16_t*)(ws + WS_XB), (const bf16_t*)(ws + WS_W5), MT, 1536, 1024}; pg8::StaticOrder S; S.init(MT, 1536, G, bid);
                Epi5 E{ws, p->out};
                pg8::gemm_phase<Epi5>(lds, g, S, E); SEAM(14);
            }
            if (IN(15)) { attn_phase(lds, p); SEAM(15); }
            if (IN(16)) {
                pg8::Gemm g{(const bf16_t*)(ws + WS_XB), (const bf16_t*)(ws + WS_W6), MT, 1024, 1024}; pg8::StaticOrder S; S.init(MT, 1024, G, bid);
                Epi2 E{ws}; pg8::gemm_phase<Epi2>(lds, g, S, E); SEAM(16);
            }
            if (IN(17)) { x_phase<1, false>(p, p->in[6] + D); SEAM(17); }
        }
    }
    if (IN(20)) { x_phase<1, true>(p, p->in[8] + D); }
#undef IN
#undef SEAM
#undef p
#undef ws
#undef G
#undef bid
}

extern "C" void kernel_launch(void* const* d_in, const int* in_sizes, int n_in, void* d_out, int out_size, void* d_ws, size_t ws_size, hipStream_t stream) {
    static int grid = 0;
    if (!grid) {
        if (n_in != 20 || ws_size < WS_END) { fprintf(stderr, "kernel_launch: unexpected n_in %d / ws_size %zu (need %zu)\n", n_in, ws_size, (size_t)WS_END); return; }
        int dev = 0, cus = 0, per_cu = 0;
        hipGetDevice(&dev); hipDeviceGetAttribute(&cus, hipDeviceAttributeMultiprocessorCount, dev);
        hipFuncSetAttribute((const void*)mega, hipFuncAttributeMaxDynamicSharedMemorySize, LDS_BYTES);
        hipOccupancyMaxActiveBlocksPerMultiprocessor(&per_cu, (const void*)mega, 512, LDS_BYTES);
        if (per_cu < 1) { fprintf(stderr, "kernel_launch: occupancy query says %d blocks per CU\n", per_cu); per_cu = 1; }
        grid = cus * 1;
    }
    Params p{};
    for (int i = 0; i < 20; ++i) p.in[i] = (const float*)d_in[i];
    p.out = (float*)d_out; p.ws = (unsigned char*)d_ws;
#if MK_ONE_LAUNCH
    int lo = 0, hi = NPHASE;
    void* args[] = {&p, &lo, &hi};
    hipError_t e = hipLaunchCooperativeKernel((const void*)mega, dim3(grid), dim3(512), args, LDS_BYTES, stream);
    if (e != hipSuccess) fprintf(stderr, "cooperative launch failed: %s (grid %d)\n", hipGetErrorString(e), grid);
#else
    for (int ph = 0; ph < NPHASE; ++ph) hipLaunchKernelGGL(mega, dim3(grid), dim3(512), LDS_BYTES, stream, p, ph, ph + 1);
#endif
}
```

```cpp
#include <hip/hip_runtime.h>
#include <hip/hip_cooperative_groups.h>
#include <cstdio>
#include <cstdint>
namespace cg = cooperative_groups;

#ifndef PROBE_DUP
#define PROBE_DUP 0
#define PROBE_REP 1
#endif
#ifndef MK_ONE_LAUNCH
#define MK_ONE_LAUNCH 1
#endif

#define LAS __attribute__((address_space(3)))
typedef unsigned short bf16_t;
typedef short bf16x8 __attribute__((ext_vector_type(8)));
typedef float f32x4 __attribute__((ext_vector_type(4)));
typedef float f32x2 __attribute__((ext_vector_type(2)));
typedef float f32x16 __attribute__((ext_vector_type(16)));
typedef unsigned u32x4 __attribute__((ext_vector_type(4)));
typedef unsigned u32x2 __attribute__((ext_vector_type(2)));

constexpr int D = 1024, TP = 8192, MP = 32768, MS = 512, MT = MP + MS, DFF = 2816;
constexpr float EPS = 1e-6f;
constexpr size_t MiB = 1u << 20;
constexpr size_t WS_W1 = 0, WS_W2 = 8 * MiB, WS_W3 = 10 * MiB, WS_W4 = 21 * MiB, WS_W5 = 27 * MiB, WS_W6 = 30 * MiB, WS_W7 = 32 * MiB, WS_W8 = 43 * MiB;
constexpr size_t WS_ROPE = 49 * MiB, WS_RS = 51 * MiB, WS_LB = 51 * MiB + 512 * 1024, WS_SSQ = 52 * MiB;
constexpr size_t WS_XB = 56 * MiB, WS_O = 121 * MiB, WS_ST = 121 * MiB;
constexpr size_t WS_BIG = 251 * MiB;
constexpr size_t WS_QH = WS_BIG, WS_KK = WS_BIG + 33 * MiB, WS_VV = WS_BIG + 66 * MiB, WS_GG = WS_BIG + 99 * MiB, WS_BB = WS_BIG + 132 * MiB;
constexpr size_t WS_MIX = WS_BIG, WS_H = WS_BIG + 65 * MiB;
constexpr size_t WS_KB = WS_BIG + 65 * MiB, WS_VB = WS_BIG + 82 * MiB, WS_QB = WS_BIG + 99 * MiB;
constexpr size_t WS_END = WS_BIG + 244 * MiB;
constexpr size_t OUT_Y = 0, OUT_STP = 34078720, OUT_STS = 34603008, OUT_CKP = 36700160, OUT_CVP = 36831232, OUT_CKS = 36962304, OUT_CVS = 37486592;

constexpr int LDS_BYTES = 131072;

struct Params { const float* in[20]; float* out; unsigned char* ws; };
typedef const Params __attribute__((address_space(4)))* KP;
__device__ __forceinline__ KP kparams() { KP k = (KP)__builtin_amdgcn_kernarg_segment_ptr(); asm volatile("" : "+s"(k)); return k; }

__device__ __forceinline__ unsigned pk2(float lo, float hi) { unsigned r; asm("v_cvt_pk_bf16_f32 %0, %1, %2" : "=v"(r) : "v"(lo), "v"(hi)); return r; }
__device__ __forceinline__ float bflo(unsigned u) { return __uint_as_float(u << 16); }
__device__ __forceinline__ float bfhi(unsigned u) { return __uint_as_float(u & 0xffff0000u); }
__device__ __forceinline__ float frcp(float x) { return __builtin_amdgcn_rcpf(x); }
__device__ __forceinline__ float siluf(float v) { float c = fminf(fmaxf(v, -30.f), 30.f); return v * frcp(1.f + __expf(-c)); }
__device__ __forceinline__ float wave_sum(float v) {
#pragma unroll
    for (int o = 1; o < 64; o <<= 1) v += __shfl_xor(v, o);
    return v;
}
#define LDS_WAIT() asm volatile("s_waitcnt lgkmcnt(0)" ::: "memory")
__device__ __forceinline__ int o_tid() { int t = threadIdx.x; asm volatile("" : "+v"(t)); return t; }
__device__ __forceinline__ int o_bid() { int t = blockIdx.x; asm volatile("" : "+s"(t)); return t; }
__device__ __forceinline__ int o_grid() { int t = gridDim.x; asm volatile("" : "+s"(t)); return t; }

namespace pg8 {
constexpr int BM = 256, BK = 64, HALF = 128, HTB = HALF * BK * 2, STAGE_BYTES = 8 * HTB, NXCD = 8, WGM = 8;
__host__ __device__ __forceinline__ int lds_byte(int r, int c) { const int st = (r >> 4) * 2 + (c >> 5), rr = r & 15, cc = c & 31, ob = rr * 64 + cc * 2; return st * 1024 + (ob ^ (((ob >> 9) & 1) << 5)); }
__host__ __device__ __forceinline__ void stage_rc(int b, int& R, int& C) { const int st = b / 1024, sb = b % 1024, swz = sb ^ (((sb >> 9) & 1) << 5); R = (st >> 1) * 16 + swz / 64; C = (st & 1) * 32 + (swz % 64) / 2; }
__host__ __device__ __forceinline__ int perm32(int rho) { const int n = rho >> 4, i = rho & 15; return 8 * (i >> 2) + 4 * n + (i & 3); }
struct Unit { int pm, pn; };
struct Gemm { const bf16_t* A; const bf16_t* Bt; int M, N, K; };
struct StaticOrder {
    int nM, nN, nwg, G, c;
    __device__ void init(int M, int N, int G_, int c_) { nM = M / BM; nN = N / BM; nwg = nM * nN; G = G_; c = c_; }
    __device__ bool next(int i, Unit& u) const {
        const long L = (long)i * G + c; if (L >= nwg) return false;
        int wgid = (int)L; { const int q = nwg / NXCD, r = nwg % NXCD, xcd = wgid % NXCD, off = wgid / NXCD; wgid = (xcd < r ? xcd * (q + 1) : r * (q + 1) + (xcd - r) * q) + off; }
        const int nig = WGM * nN, gid = wgid / nig, fm = gid * WGM, gsz = (nM - fm) < WGM ? (nM - fm) : WGM;
        u.pm = fm + ((wgid % nig) % gsz); u.pn = (wgid % nig) / gsz; return true;
    }
};
template <class Epi>
__device__ __forceinline__ void gemm_phase(LAS unsigned char* lds, const Gemm g, const StaticOrder& S, const Epi& E) {
    const int tid = o_tid(), wid = __builtin_amdgcn_readfirstlane(tid >> 6), lane = tid & 63, wr = wid >> 2, wc = wid & 3, fr = lane & 15, fq = lane >> 4;
    const int K = g.K, nt = K / BK;
    unsigned voffA[2], voffB[2];
#pragma unroll
    for (int i = 0; i < 2; ++i) { int R, C; stage_rc(tid * 16 + i * 8192, R, C); const int Rb = (R & ~31) + perm32(R & 31);
        voffA[i] = (unsigned)(R * K + C) * 2u; voffB[i] = (unsigned)(Rb * K + C) * 2u; }
    const size_t kstep = (size_t)(BK * 2);
    const size_t hstep = (size_t)HALF * K * 2;
    const size_t tstep = 2 * hstep;
    const unsigned ldsw = (unsigned)wid * 1024u;
    const int aoff = lds_byte(wr * 64 + fr, fq * 8), boff = lds_byte(wc * 32 + fr, fq * 8);
#define PG8_SA(b, h) (((b) * 2 + (h)) * HTB)
#define PG8_SB(b, h) ((4 + (b) * 2 + (h)) * HTB)
#define PG8_STAGE(bufoff, gbase, voff) do { _Pragma("unroll") for (int _i = 0; _i < 2; ++_i) \
        __builtin_amdgcn_global_load_lds((const unsigned*)((const char*)(gbase) + (voff)[_i]), (LAS unsigned*)(lds + (bufoff) + ldsw + _i * 8192), 16, 0, 0); } while (0)
#define PG8_LDA(dst, b, h) do { _Pragma("unroll") for (int m = 0; m < 4; ++m) _Pragma("unroll") for (int k = 0; k < 2; ++k) dst[m][k] = *(const LAS bf16x8*)(lds + PG8_SA(b, h) + aoff + m * 2048 + k * 1024); } while (0)
#define PG8_LDB(dst, b, h) do { _Pragma("unroll") for (int n = 0; n < 2; ++n) _Pragma("unroll") for (int k = 0; k < 2; ++k) dst[n][k] = *(const LAS bf16x8*)(lds + PG8_SB(b, h) + boff + n * 2048 + k * 1024); } while (0)
#define PG8_MMA(ai, bj, At, Bt) do { __builtin_amdgcn_s_setprio(1); _Pragma("unroll") for (int m = 0; m < 4; ++m) _Pragma("unroll") for (int n = 0; n < 2; ++n) _Pragma("unroll") for (int k = 0; k < 2; ++k) \
        acc[ai][bj][m][n] = __builtin_amdgcn_mfma_f32_16x16x32_bf16(Bt[n][k], At[m][k], acc[ai][bj][m][n], 0, 0, 0); __builtin_amdgcn_s_setprio(0); } while (0)
#define PG8_WAIT_V(n) asm volatile("s_waitcnt vmcnt(" #n ")" ::: "memory")
#define PG8_WAIT_L(n) asm volatile("s_waitcnt lgkmcnt(" #n ")" ::: "memory")
#define PG8_BAR __builtin_amdgcn_s_barrier()
#define PG8_SCHED __builtin_amdgcn_sched_barrier(0)
    Unit cur, nxt; int ui = 0;
    if (!S.next(0, cur)) return;
    f32x4 acc[2][2][4][2];
#pragma unroll
    for (int a = 0; a < 2; ++a)
#pragma unroll
        for (int b = 0; b < 2; ++b)
#pragma unroll
            for (int m = 0; m < 4; ++m)
#pragma unroll
                for (int n = 0; n < 2; ++n) acc[a][b][m][n] = (f32x4){0.f, 0.f, 0.f, 0.f};
    bf16x8 At[4][2], B0[2][2], B1[2][2];
    const char* cA = (const char*)g.A + (size_t)cur.pm * tstep; const char* cB = (const char*)g.Bt + (size_t)cur.pn * tstep;
    PG8_STAGE(PG8_SB(0, 0), cB, voffB); PG8_STAGE(PG8_SB(0, 1), cB + hstep, voffB); PG8_STAGE(PG8_SA(0, 0), cA, voffA); PG8_STAGE(PG8_SA(0, 1), cA + hstep, voffA);
    if (wr == 1) PG8_BAR;
    PG8_WAIT_V(2); PG8_BAR;
    PG8_STAGE(PG8_SB(1, 0), cB + kstep, voffB); PG8_STAGE(PG8_SA(1, 0), cA + kstep, voffA); PG8_STAGE(PG8_SB(1, 1), cB + hstep + kstep, voffB);
    PG8_WAIT_V(6); PG8_BAR;
    for (;;) {
        const bool has_next = S.next(ui + 1, nxt);
        const char* nA = has_next ? (const char*)g.A + (size_t)nxt.pm * tstep : cA; const char* nB = has_next ? (const char*)g.Bt + (size_t)nxt.pn * tstep : cB;
        for (int t = 0; t < nt; t += 2) {
            const bool last = (t == nt - 2);
            const char* a1 = cA + (size_t)(t + 1) * kstep;
            const char* a2 = last ? nA : cA + (size_t)(t + 2) * kstep; const char* b2 = last ? nB : cB + (size_t)(t + 2) * kstep;
            const char* a3 = a2 + kstep; const char* b3 = b2 + kstep;
            PG8_LDB(B0, 0, 0); PG8_LDB(B1, 0, 1); PG8_SCHED; PG8_LDA(At, 0, 0); PG8_STAGE(PG8_SA(1, 1), a1 + hstep, voffA);
            PG8_WAIT_V(8); PG8_WAIT_L(0); PG8_BAR; PG8_MMA(0, 0, At, B0); PG8_MMA(0, 1, At, B1); PG8_BAR; PG8_SCHED;
            PG8_LDA(At, 0, 1); PG8_STAGE(PG8_SB(0, 0), b2, voffB); PG8_STAGE(PG8_SB(0, 1), b2 + hstep, voffB); PG8_STAGE(PG8_SA(0, 0), a2, voffA);
            PG8_WAIT_V(8); PG8_WAIT_L(0); PG8_BAR; PG8_MMA(1, 0, At, B0); PG8_MMA(1, 1, At, B1); PG8_BAR; PG8_SCHED;
            PG8_LDB(B0, 1, 0); PG8_LDB(B1, 1, 1); PG8_SCHED; PG8_LDA(At, 1, 0); PG8_STAGE(PG8_SA(0, 1), a2 + hstep, voffA);
            PG8_WAIT_V(8); PG8_WAIT_L(0); PG8_BAR; PG8_MMA(0, 0, At, B0); PG8_MMA(0, 1, At, B1); PG8_BAR; PG8_SCHED;
            PG8_LDA(At, 1, 1); PG8_STAGE(PG8_SB(1, 0), b3, voffB); PG8_STAGE(PG8_SB(1, 1), b3 + hstep, voffB); PG8_STAGE(PG8_SA(1, 0), a3, voffA);
            PG8_WAIT_V(8); PG8_WAIT_L(0); PG8_BAR; PG8_MMA(1, 0, At, B0); PG8_MMA(1, 1, At, B1); PG8_BAR; PG8_SCHED;
        }
        if (wr == 0) PG8_BAR;
        E(acc, cur, wr, wc, fr, fq);
        if (!has_next) break;
#pragma unroll
        for (int a = 0; a < 2; ++a)
#pragma unroll
            for (int b = 0; b < 2; ++b)
#pragma unroll
                for (int m = 0; m < 4; ++m)
#pragma unroll
                    for (int n = 0; n < 2; ++n) acc[a][b][m][n] = (f32x4){0.f, 0.f, 0.f, 0.f};
        cur = nxt; cA = nA; cB = nB; ++ui;
        if (wr == 1) PG8_BAR;
    }
    PG8_WAIT_V(0);
    PG8_BAR;
#undef PG8_SA
#undef PG8_SB
#undef PG8_STAGE
#undef PG8_LDA
#undef PG8_LDB
#undef PG8_MMA
#undef PG8_WAIT_V
#undef PG8_WAIT_L
#undef PG8_BAR
#undef PG8_SCHED
}
}
using pg8::Unit;

__device__ __forceinline__ u32x4 pack8(const f32x4 a, const f32x4 b) { u32x4 o; o.x = pk2(a[0], a[1]); o.y = pk2(a[2], a[3]); o.z = pk2(b[0], b[1]); o.w = pk2(b[2], b[3]); return o; }

struct Epi1 {
    unsigned char* ws; int rowbase;
    __device__ __forceinline__ void operator()(f32x4 (&acc)[2][2][4][2], const Unit& u, int wr, int wc, int fr, int fq) const {
        bf16_t* KK = (bf16_t*)(ws + WS_KK); float* BB = (float*)(ws + WS_BB); const float* RS = (const float*)(ws + WS_RS); const float* LB = (const float*)(ws + WS_LB);
        const int type = u.pn >> 2, cs = (u.pn & 3) * 256 + wc * 32 + fq * 8;
        int lrow0 = u.pm * 256 + wr * 64 + fr; asm volatile("" : "+v"(lrow0));
#pragma unroll
        for (int ai = 0; ai < 2; ++ai)
#pragma unroll
            for (int m = 0; m < 4; ++m) { const float rs = RS[rowbase + lrow0 + ai * 128 + m * 16];
#pragma unroll
                for (int bj = 0; bj < 2; ++bj)
#pragma unroll
                    for (int n = 0; n < 2; ++n) acc[ai][bj][m][n] *= rs; }
        if (type != 1) {
            bf16_t* O = (bf16_t*)(ws + WS_QH + (size_t)(type == 0 ? 0 : (type == 2 ? 66 : 99)) * MiB);
#pragma unroll
            for (int ai = 0; ai < 2; ++ai)
#pragma unroll
                for (int m = 0; m < 4; ++m) { bf16_t* rowp = O + (size_t)(lrow0 + ai * 128 + m * 16) * D + cs;
#pragma unroll
                    for (int bj = 0; bj < 2; ++bj) { f32x4 v0 = acc[ai][bj][m][0], v1 = acc[ai][bj][m][1];
                        if (type != 2) {
#pragma unroll
                            for (int j = 0; j < 4; ++j) { v0[j] = siluf(v0[j]); v1[j] = siluf(v1[j]); } }
                        *(u32x4*)(rowp + bj * 128) = pack8(v0, v1); } }
        } else {
            const bool smp = (rowbase + u.pm * 256) >= MP;
#pragma unroll
            for (int bj = 0; bj < 2; ++bj) {
                const f32x4 lb0 = *(const f32x4*)(LB + cs + bj * 128), lb1 = *(const f32x4*)(LB + cs + bj * 128 + 4);
#pragma unroll
                for (int ai = 0; ai < 2; ++ai)
#pragma unroll
                    for (int m = 0; m < 4; ++m) {
                        f32x4 k0, k1;
#pragma unroll
                        for (int j = 0; j < 4; ++j) {
                            { const float v = fminf(fmaxf(acc[ai][bj][m][0][j], -30.f), 30.f); const float kk = (1.f - lb0[j]) * frcp(1.f + __expf(v)); k0[j] = kk; acc[ai][bj][m][0][j] = __logf(1.f - kk); }
                            { const float v = fminf(fmaxf(acc[ai][bj][m][1][j], -30.f), 30.f); const float kk = (1.f - lb1[j]) * frcp(1.f + __expf(v)); k1[j] = kk; acc[ai][bj][m][1][j] = __logf(1.f - kk); }
                        }
                        *(u32x4*)(KK + (size_t)(lrow0 + ai * 128 + m * 16) * D + cs + bj * 128) = pack8(k0, k1);
                    }
            }
#pragma unroll
            for (int ai = 0; ai < 2; ++ai)
#pragma unroll
                for (int bj = 0; bj < 2; ++bj)
#pragma unroll
                    for (int n = 0; n < 2; ++n)
#pragma unroll
                        for (int j = 0; j < 4; ++j) {
                            float v[4], tot[4];
#pragma unroll
                            for (int m = 0; m < 4; ++m) { float x = acc[ai][bj][m][n][j];
#pragma unroll
                                for (int d = 1; d < 16; d <<= 1) { const float t = __shfl_up(x, d, 16); if (fr >= d) x += t; }
                                v[m] = x; tot[m] = __shfl(x, 15, 16); }
                            if (!smp) { v[1] += tot[0]; v[2] += tot[0] + tot[1]; v[3] += (tot[0] + tot[1]) + tot[2]; }
                            else { v[1] += tot[0]; v[3] += tot[2]; }
#pragma unroll
                            for (int m = 0; m < 4; ++m) acc[ai][bj][m][n][j] = v[m];
                        }
#pragma unroll
            for (int ai = 0; ai < 2; ++ai)
#pragma unroll
                for (int m = 0; m < 4; ++m) { float* rowp = BB + (size_t)(lrow0 + ai * 128 + m * 16) * D + cs;
#pragma unroll
                    for (int bj = 0; bj < 2; ++bj) { *(f32x4*)(rowp + bj * 128) = acc[ai][bj][m][0]; *(f32x4*)(rowp + bj * 128 + 4) = acc[ai][bj][m][1]; } }
        }
    }
};
struct Epi2 {
    unsigned char* ws;
    __device__ __forceinline__ void operator()(f32x4 (&acc)[2][2][4][2], const Unit& u, int wr, int wc, int fr, int fq) const {
        bf16_t* MIX = (bf16_t*)(ws + WS_MIX); float* SSQ = (float*)(ws + WS_SSQ); asm volatile("" : "+v"(fr));
#pragma unroll
        for (int ai = 0; ai < 2; ++ai)
#pragma unroll
            for (int m = 0; m < 4; ++m) { const int row = u.pm * 256 + ai * 128 + wr * 64 + m * 16 + fr; float ss = 0.f;
                bf16_t* rowp = MIX + (size_t)row * D + u.pn * 256 + wc * 32 + fq * 8;
#pragma unroll
                for (int bj = 0; bj < 2; ++bj) { const f32x4 v0 = acc[ai][bj][m][0], v1 = acc[ai][bj][m][1];
#pragma unroll
                    for (int j = 0; j < 4; ++j) ss += v0[j] * v0[j] + v1[j] * v1[j];
                    *(u32x4*)(rowp + bj * 128) = pack8(v0, v1); }
                ss += __shfl_xor(ss, 16); ss += __shfl_xor(ss, 32);
                if (fq == 0) SSQ[(size_t)row * 16 + u.pn * 4 + wc] = ss; }
    }
};
struct Epi3 {
    unsigned char* ws;
    __device__ __forceinline__ void operator()(f32x4 (&acc)[2][2][4][2], const Unit& u, int wr, int wc, int fr, int fq) const {
        bf16_t* H = (bf16_t*)(ws + WS_H); const float* RS = (const float*)(ws + WS_RS); asm volatile("" : "+v"(fr));
#pragma unroll
        for (int ai = 0; ai < 2; ++ai)
#pragma unroll
            for (int m = 0; m < 4; ++m) { const int row = u.pm * 256 + ai * 128 + wr * 64 + m * 16 + fr; const float rs = RS[row];
                f32x4 h0, h1;
#pragma unroll
                for (int j = 0; j < 4; ++j) { h0[j] = siluf(acc[ai][0][m][0][j] * rs) * (acc[ai][1][m][0][j] * rs); h1[j] = siluf(acc[ai][0][m][1][j] * rs) * (acc[ai][1][m][1][j] * rs); }
                *(u32x4*)(H + (size_t)row * DFF + u.pn * 128 + wc * 32 + fq * 8) = pack8(h0, h1); }
    }
};
struct Epi5 {
    unsigned char* ws; float* out;
    __device__ __forceinline__ void operator()(f32x4 (&acc)[2][2][4][2], const Unit& u, int wr, int wc, int fr, int fq) const {
        bf16_t* Qb = (bf16_t*)(ws + WS_QB); const float* RS = (const float*)(ws + WS_RS); const float* ROPE = (const float*)(ws + WS_ROPE); asm volatile("" : "+v"(fr));
        const int d1 = fq * 8;
#pragma unroll
        for (int ai = 0; ai < 2; ++ai)
#pragma unroll
            for (int m = 0; m < 4; ++m) { const int row = u.pm * 256 + ai * 128 + wr * 64 + m * 16 + fr; const float rs = RS[row];
                int pos, crow, cb; bool smp = row >= MP;
                if (!smp) { const int t = row & (TP - 1); pos = t; cb = row >> 13; crow = t - (TP - 128); }
                else { const int lr = row - MP; const int t = lr & 31; pos = 2048 + t; cb = lr >> 5; crow = 96 + t; }
                f32x4 x1a = acc[ai][0][m][0] * rs, x1b = acc[ai][0][m][1] * rs, x2a = acc[ai][1][m][0] * rs, x2b = acc[ai][1][m][1] * rs;
                if (u.pn != 1) {
                    const f32x4* rp = (const f32x4*)(ROPE + ((size_t)pos * 32 + d1) * 2);
                    const f32x4 r0 = rp[0], r1 = rp[1], r2 = rp[2], r3 = rp[3];
                    f32x4 ca = {r0[0], r0[2], r1[0], r1[2]}, sa = {r0[1], r0[3], r1[1], r1[3]}, cb4 = {r2[0], r2[2], r3[0], r3[2]}, sb4 = {r2[1], r2[3], r3[1], r3[3]};
                    const f32x4 o1a = x1a * ca - x2a * sa, o2a = x2a * ca + x1a * sa, o1b = x1b * cb4 - x2b * sb4, o2b = x2b * cb4 + x1b * sb4;
                    x1a = o1a; x2a = o2a; x1b = o1b; x2b = o2b;
                }
                if (u.pn >= 2) {
                    const int hq = (u.pn - 2) * 4 + wc; bf16_t* q = Qb + (size_t)row * D + hq * 64 + d1;
                    *(u32x4*)q = pack8(x1a * 0.125f, x1b * 0.125f); *(u32x4*)(q + 32) = pack8(x2a * 0.125f, x2b * 0.125f);
                } else {
                    bf16_t* kb = (bf16_t*)(ws + WS_KB + (size_t)(u.pn == 0 ? 0 : 17) * MiB) + (size_t)row * 256 + wc * 64 + d1;
                    *(u32x4*)kb = pack8(x1a, x1b); *(u32x4*)(kb + 32) = pack8(x2a, x2b);
                    if (crow >= 0) {
                        float* co = out + (smp ? (u.pn == 0 ? OUT_CKS : OUT_CVS) : (u.pn == 0 ? OUT_CKP : OUT_CVP)) + ((size_t)(cb * 128 + crow) * 4 + wc) * 64 + d1;
                        *(f32x4*)co = x1a; *(f32x4*)(co + 4) = x1b; *(f32x4*)(co + 32) = x2a; *(f32x4*)(co + 36) = x2b;
                    }
                }
            }
    }
};

__device__ __forceinline__ void tr_item(const float* W, int ldw, int col0, const float* fold, bf16_t* WT, int K, int drow0, int k0, LAS float* scr, int lane) {
    float wreg[32];
#pragma unroll
    for (int i = 0; i < 32; ++i) { const int kk = 2 * i + (lane >> 5); wreg[i] = W[(size_t)(k0 + kk) * ldw + col0 + (lane & 31)]; }
    if (fold) {
#pragma unroll
        for (int i = 0; i < 32; ++i) wreg[i] *= fold[k0 + 2 * i + (lane >> 5)]; }
#pragma unroll
    for (int i = 0; i < 32; ++i) scr[(2 * i + (lane >> 5)) * 33 + (lane & 31)] = wreg[i];
    LDS_WAIT();
    const int c = lane & 7;
#pragma unroll
    for (int j = 0; j < 4; ++j) { const int n = (lane >> 3) + 8 * j; const LAS float* s = scr + (8 * c) * 33 + n;
        u32x4 o; o.x = pk2(s[0 * 33], s[1 * 33]); o.y = pk2(s[2 * 33], s[3 * 33]); o.z = pk2(s[4 * 33], s[5 * 33]); o.w = pk2(s[6 * 33], s[7 * 33]);
        *(u32x4*)(WT + (size_t)(drow0 + n) * K + k0 + 8 * c) = o; }
    LDS_WAIT();
}
__device__ __forceinline__ const float* xrow_ptr(KP p, int row) { return row < MP ? p->in[0] + (size_t)row * D : p->in[1] + (size_t)(row - MP) * D; }

__device__ __forceinline__ void p0_prologue(LAS unsigned char* lds, KP p) {
    const int tid = o_tid(), lane = tid & 63, wave = tid >> 6;
    LAS float* scr = (LAS float*)(lds + wave * 16384);
    const int bidx = o_bid(), gdim = o_grid();
    const int gw = bidx * 8 + wave, NGW = gdim * 8;
    unsigned char* ws = p->ws;
    constexpr int I1 = 16 * 128, I2 = 16 * 32, I3 = 16 * 176, I4 = 44 * 32, I5 = 16 * 48, I6 = 16 * 32, I7 = I3, I8 = I4;
    constexpr int NIT = I1 + I2 + I3 + I4 + I5 + I6 + I7 + I8;
    for (int it = gw; it < NIT; it += NGW) {
        int r = it;
        if (r < I1) { const int nb = r % 128, kb = r / 128; tr_item(p->in[11], 4096, 32 * nb, p->in[5], (bf16_t*)(ws + WS_W1), 1024, 32 * nb, 64 * kb, scr, lane); continue; } r -= I1;
        if (r < I2) { const int nb = r % 32, kb = r / 32; tr_item(p->in[14], 1024, 32 * nb, nullptr, (bf16_t*)(ws + WS_W2), 1024, 32 * nb, 64 * kb, scr, lane); continue; } r -= I2;
        if (r < I3) { const int nb = r % 176, kb = r / 176; const int rho = 32 * nb, col = ((rho >> 7) & 1) * DFF + 128 * (rho >> 8) + (rho & 127);
            tr_item(p->in[9], 2 * DFF, col, p->in[7], (bf16_t*)(ws + WS_W3), 1024, rho, 64 * kb, scr, lane); continue; } r -= I3;
        if (r < I4) { const int nb = r % 32, kb = r / 32; tr_item(p->in[10], 1024, 32 * nb, nullptr, (bf16_t*)(ws + WS_W4), DFF, 32 * nb, 64 * kb, scr, lane); continue; } r -= I4;
        if (r < I5) { const int nb = r % 48, kb = r / 48; const int rho = 32 * nb, cc = 256 * (rho >> 8) + 64 * ((rho & 127) >> 5) + 32 * ((rho >> 7) & 1);
            if (cc < 512) tr_item(p->in[16], 512, cc, p->in[15], (bf16_t*)(ws + WS_W5), 1024, rho, 64 * kb, scr, lane);
            else tr_item(p->in[17], 1024, cc - 512, p->in[5] + D, (bf16_t*)(ws + WS_W5), 1024, rho, 64 * kb, scr, lane);
            continue; } r -= I5;
        if (r < I6) { const int nb = r % 32, kb = r / 32; tr_item(p->in[19], 1024, 32 * nb, nullptr, (bf16_t*)(ws + WS_W6), 1024, 32 * nb, 64 * kb, scr, lane); continue; } r -= I6;
        if (r < I7) { const int nb = r % 176, kb = r / 176; const int rho = 32 * nb, col = ((rho >> 7) & 1) * DFF + 128 * (rho >> 8) + (rho & 127);
            tr_item(p->in[9] + (size_t)D * 2 * DFF, 2 * DFF, col, p->in[7] + D, (bf16_t*)(ws + WS_W7), 1024, rho, 64 * kb, scr, lane); continue; } r -= I7;
        { const int nb = r % 32, kb = r / 32; tr_item(p->in[10] + (size_t)DFF * D, 1024, 32 * nb, nullptr, (bf16_t*)(ws + WS_W8), DFF, 32 * nb, 64 * kb, scr, lane); }
    }
    bf16_t* XB = (bf16_t*)(ws + WS_XB); float* RS = (float*)(ws + WS_RS);
    for (int row0 = gw; row0 < MT; row0 += 2 * NGW) {
        f32x4 v[2][4];
#pragma unroll
        for (int q = 0; q < 2; ++q) { const int row = row0 + q * NGW; const f32x4* xr = (const f32x4*)xrow_ptr(p, row < MT ? row : row0) + lane;
#pragma unroll
            for (int j = 0; j < 4; ++j) v[q][j] = xr[64 * j]; }
#pragma unroll
        for (int q = 0; q < 2; ++q) { const int row = row0 + q * NGW; float s = 0.f;
#pragma unroll
            for (int j = 0; j < 4; ++j) s += (v[q][j][0] * v[q][j][0] + v[q][j][1] * v[q][j][1]) + (v[q][j][2] * v[q][j][2] + v[q][j][3] * v[q][j][3]);
            s = wave_sum(s);
            if (row < MT) { u32x2* o = (u32x2*)(XB + (size_t)row * D) + lane;
#pragma unroll
                for (int j = 0; j < 4; ++j) { u32x2 w; w.x = pk2(v[q][j][0], v[q][j][1]); w.y = pk2(v[q][j][2], v[q][j][3]); o[64 * j] = w; }
                if (lane == 0) RS[row] = rsqrtf(s * (1.f / D) + EPS); }
        }
    }
    const int gt = bidx * 512 + tid, NGT = gdim * 512;
    float* ROPE = (float*)(ws + WS_ROPE);
    for (int i = gt; i < TP * 32; i += NGT) { const int pos = i >> 5, d = i & 31;
        const float inv = exp2f(-(float)d * (13.287712379549449f / 32.f));
        const float ang = (float)pos * inv;
        double rev = (double)ang * 0.15915494309189535; rev -= __builtin_rint(rev);
        const float rr = (float)rev;
        ROPE[2 * i] = __builtin_amdgcn_cosf(rr); ROPE[2 * i + 1] = __builtin_amdgcn_sinf(rr); }
    float* LB = (float*)(ws + WS_LB);
    for (int i = gt; i < D; i += NGT) { const float a0 = p->in[12][i], a1 = p->in[12][D + i]; LB[i] = 1.f / (1.f + expf(a1 - a0)); }
    for (int i = gt; i < 16 * 96 * 64; i += NGT) { const int b = i / (96 * 64), rem = i % (96 * 64);
        const f32x4 kv = *((const f32x4*)(p->in[3] + (size_t)b * 32768 + 32 * 256) + rem), vv = *((const f32x4*)(p->in[4] + (size_t)b * 32768 + 32 * 256) + rem);
        *((f32x4*)(p->out + OUT_CKS + (size_t)b * 32768) + rem) = kv; *((f32x4*)(p->out + OUT_CVS + (size_t)b * 32768) + rem) = vv; }
}

__device__ __forceinline__ f32x16 mfma32(bf16x8 a, bf16x8 b, f32x16 c) { return __builtin_amdgcn_mfma_f32_32x32x16_bf16(a, b, c, 0, 0, 0); }
__device__ __forceinline__ f32x16 zero16() { f32x16 z; for (int i = 0; i < 16; ++i) z[i] = 0.f; return z; }

struct HUnit { int row0, L, h, sb; };
__device__ __forceinline__ HUnit hunit(int u, int hf) { HUnit r;
    if (u < 2048) { r.row0 = (2 * hf + (u >> 10)) * TP + 64 * ((u >> 3) & 127); r.L = 64; r.h = u & 7; r.sb = -1; }
    else { const int uu = u - 2048; r.sb = uu >> 3; r.h = uu & 7; r.row0 = MP + 32 * r.sb; r.L = 32; }
    return r; }

__device__ __forceinline__ void h1_phase(LAS unsigned char* lds, KP p, int hf) {
    const int tid = o_tid(), lane = tid & 63, w = tid >> 6, r32 = lane & 31, hh = lane >> 5;
    LAS bf16_t* KT = (LAS bf16_t*)lds; LAS bf16_t* VT = KT + 128 * 72;
    const int nunits = hf ? 2176 : 2048, rowbase = hf ? 16384 : 0;
    const float* BB = (const float*)(p->ws + WS_BB); const bf16_t* KK = (const bf16_t*)(p->ws + WS_KK); const bf16_t* VV = (const bf16_t*)(p->ws + WS_VV);
    bf16_t* ST = (bf16_t*)(p->ws + WS_ST);
    const int r = tid >> 3, c16 = (tid & 7) * 16;
    const int bidx = o_bid(), gdim = o_grid();
    for (int u = bidx; u < nunits; u += gdim) {
        const HUnit hu = hunit(u, hf); const int lrow0 = hu.row0 - rowbase;
        const size_t off = (size_t)(lrow0 + r) * D + hu.h * 128 + c16, offl = (size_t)(lrow0 + hu.L - 1) * D + hu.h * 128 + c16;
        const bool valid = r < hu.L;
#pragma unroll
        for (int q = 0; q < 2; ++q) {
            u32x4 kq = {0u, 0u, 0u, 0u}, vq = {0u, 0u, 0u, 0u}; f32x4 b0 = {0, 0, 0, 0}, b1 = b0, l0 = b0, l1 = b0;
            if (valid) { kq = *(const u32x4*)(KK + off + 8 * q); vq = *(const u32x4*)(VV + off + 8 * q);
                b0 = *(const f32x4*)(BB + off + 8 * q); b1 = *(const f32x4*)(BB + off + 8 * q + 4); l0 = *(const f32x4*)(BB + offl + 8 * q); l1 = *(const f32x4*)(BB + offl + 8 * q + 4); }
            float kt[8];
            kt[0] = bflo(kq.x) * __expf(l0[0] - b0[0]); kt[1] = bfhi(kq.x) * __expf(l0[1] - b0[1]); kt[2] = bflo(kq.y) * __expf(l0[2] - b0[2]); kt[3] = bfhi(kq.y) * __expf(l0[3] - b0[3]);
            kt[4] = bflo(kq.z) * __expf(l1[0] - b1[0]); kt[5] = bfhi(kq.z) * __expf(l1[1] - b1[1]); kt[6] = bflo(kq.w) * __expf(l1[2] - b1[2]); kt[7] = bfhi(kq.w) * __expf(l1[3] - b1[3]);
            const unsigned vw[4] = {vq.x, vq.y, vq.z, vq.w};
#pragma unroll
            for (int i = 0; i < 4; ++i) { const unsigned pk = pk2(kt[2 * i], kt[2 * i + 1]); const int cc = c16 + 8 * q + 2 * i;
                KT[cc * 72 + r] = (bf16_t)(pk & 0xffffu); KT[(cc + 1) * 72 + r] = (bf16_t)(pk >> 16);
                VT[cc * 72 + r] = (bf16_t)(vw[i] & 0xffffu); VT[(cc + 1) * 72 + r] = (bf16_t)(vw[i] >> 16); }
        }
        __syncthreads();
        const int dvt = w >> 1, dk0 = (w & 1) * 2;
        f32x16 acc0 = zero16(), acc1 = zero16();
#pragma unroll
        for (int ks = 0; ks < 4; ++ks) {
            const bf16x8 a = *(const LAS bf16x8*)(VT + (dvt * 32 + r32) * 72 + ks * 16 + hh * 8);
            const bf16x8 bq0 = *(const LAS bf16x8*)(KT + (dk0 * 32 + r32) * 72 + ks * 16 + hh * 8);
            const bf16x8 bq1 = *(const LAS bf16x8*)(KT + ((dk0 + 1) * 32 + r32) * 72 + ks * 16 + hh * 8);
            acc0 = mfma32(a, bq0, acc0); acc1 = mfma32(a, bq1, acc1);
        }
        bf16_t* st = ST + (size_t)u * 16384;
        if (hu.L == 64) {
#pragma unroll
            for (int reg = 0; reg < 16; ++reg) { const int dv = dvt * 32 + (reg & 3) + 8 * (reg >> 2) + 4 * hh;
                st[dv * 128 + dk0 * 32 + r32] = (bf16_t)(pk2(acc0[reg], 0.f) & 0xffffu); st[dv * 128 + (dk0 + 1) * 32 + r32] = (bf16_t)(pk2(acc1[reg], 0.f) & 0xffffu); }
        } else {
            const float* s0p = p->in[2] + (size_t)(hu.sb * 8 + hu.h) * 16384; float* sop = p->out + OUT_STS + (size_t)(hu.sb * 8 + hu.h) * 16384;
            const float* bl = BB + (size_t)(lrow0 + 31) * D + hu.h * 128;
#pragma unroll
            for (int jt = 0; jt < 2; ++jt) { const int dk = (dk0 + jt) * 32 + r32; const float dec = __expf(bl[dk]);
#pragma unroll
                for (int reg = 0; reg < 16; ++reg) { const int dv = dvt * 32 + (reg & 3) + 8 * (reg >> 2) + 4 * hh;
                    const float s0 = s0p[dk * 128 + dv]; const float a = jt ? acc1[reg] : acc0[reg];
                    sop[dk * 128 + dv] = dec * s0 + a; st[dv * 128 + dk] = (bf16_t)(pk2(s0, 0.f) & 0xffffu); } }
        }
        __syncthreads();
    }
}
__device__ __forceinline__ void h2_phase(KP p, int hf) {
    const int tid = o_tid(); const int bidx = o_bid(), gdim = o_grid();
    const float* BB = (const float*)(p->ws + WS_BB); unsigned* ST = (unsigned*)(p->ws + WS_ST);
    for (int it = bidx * 512 + tid; it < 16 * 8192; it += gdim * 512) {
        const int pair = it >> 13, e = it & 8191, dv = e >> 6, dk = (e & 63) * 2, bl = pair >> 3, h = pair & 7;
        float s0 = 0.f, s1 = 0.f;
        unsigned* sp = ST + ((size_t)(bl * 1024 + h) * 16384 + dv * 128 + dk) / 2;
        const float* bp = BB + (size_t)(bl * TP + 63) * D + h * 128 + dk;
        for (int c0 = 0; c0 < 128; c0 += 8) {
            unsigned uu[8]; f32x2 dd[8];
#pragma unroll
            for (int i = 0; i < 8; ++i) { uu[i] = sp[(size_t)(c0 + i) * 65536]; dd[i] = *(const f32x2*)(bp + (size_t)(c0 + i) * 64 * D); }
#pragma unroll
            for (int i = 0; i < 8; ++i) { sp[(size_t)(c0 + i) * 65536] = pk2(s0, s1); s0 = __expf(dd[i][0]) * s0 + bflo(uu[i]); s1 = __expf(dd[i][1]) * s1 + bfhi(uu[i]); }
        }
        float* so = p->out + OUT_STP + (size_t)((2 * hf + bl) * 8 + h) * 16384;
        so[dk * 128 + dv] = s0; so[(dk + 1) * 128 + dv] = s1;
    }
}
__device__ __forceinline__ void h3_phase(LAS unsigned char* lds, KP p, int hf) {
    const int tid = o_tid(), lane = tid & 63, w = tid >> 6, r32 = lane & 31, hh = lane >> 5;
    LAS bf16_t* Qs = (LAS bf16_t*)lds; LAS bf16_t* Ks = Qs + 64 * 136; LAS bf16_t* VT = Ks + 64 * 136; LAS bf16_t* Ss = VT + 128 * 72; LAS float* red = (LAS float*)(Ss + 128 * 136);
    const int nunits = hf ? 2176 : 2048, rowbase = hf ? 16384 : 0;
    const float* BB = (const float*)(p->ws + WS_BB); const bf16_t* KK = (const bf16_t*)(p->ws + WS_KK); const bf16_t* VV = (const bf16_t*)(p->ws + WS_VV);
    const bf16_t* QH = (const bf16_t*)(p->ws + WS_QH); const bf16_t* GG = (const bf16_t*)(p->ws + WS_GG);
    const bf16_t* ST = (const bf16_t*)(p->ws + WS_ST); bf16_t* O2 = (bf16_t*)(p->ws + WS_XB);
    const float* gnorm = p->in[13];
    const int r = tid >> 3, c16 = (tid & 7) * 16;
    const int bidx = o_bid(), gdim = o_grid();
    for (int u = bidx; u < nunits; u += gdim) {
        const HUnit hu = hunit(u, hf); const int lrow0 = hu.row0 - rowbase;
        const size_t off = (size_t)(lrow0 + r) * D + hu.h * 128 + c16;
        const bool valid = r < hu.L;
#pragma unroll
        for (int q = 0; q < 2; ++q) {
            u32x4 kq = {0u, 0u, 0u, 0u}, vq = kq, qq = kq; f32x4 b0 = {0, 0, 0, 0}, b1 = b0;
            if (valid) { kq = *(const u32x4*)(KK + off + 8 * q); vq = *(const u32x4*)(VV + off + 8 * q); qq = *(const u32x4*)(QH + off + 8 * q);
                b0 = *(const f32x4*)(BB + off + 8 * q); b1 = *(const f32x4*)(BB + off + 8 * q + 4); }
            float eb[8], kf[8], qf[8];
#pragma unroll
            for (int j = 0; j < 4; ++j) { eb[j] = __expf(b0[j]); eb[4 + j] = __expf(b1[j]); }
            kf[0] = bflo(kq.x); kf[1] = bfhi(kq.x); kf[2] = bflo(kq.y); kf[3] = bfhi(kq.y); kf[4] = bflo(kq.z); kf[5] = bfhi(kq.z); kf[6] = bflo(kq.w); kf[7] = bfhi(kq.w);
            qf[0] = bflo(qq.x); qf[1] = bfhi(qq.x); qf[2] = bflo(qq.y); qf[3] = bfhi(qq.y); qf[4] = bflo(qq.z); qf[5] = bfhi(qq.z); qf[6] = bflo(qq.w); qf[7] = bfhi(qq.w);
            u32x4 qo, ko;
            qo.x = pk2(qf[0] * eb[0], qf[1] * eb[1]); qo.y = pk2(qf[2] * eb[2], qf[3] * eb[3]); qo.z = pk2(qf[4] * eb[4], qf[5] * eb[5]); qo.w = pk2(qf[6] * eb[6], qf[7] * eb[7]);
            ko.x = pk2(kf[0] * frcp(eb[0]), kf[1] * frcp(eb[1])); ko.y = pk2(kf[2] * frcp(eb[2]), kf[3] * frcp(eb[3])); ko.z = pk2(kf[4] * frcp(eb[4]), kf[5] * frcp(eb[5])); ko.w = pk2(kf[6] * frcp(eb[6]), kf[7] * frcp(eb[7]));
            *(LAS u32x4*)(Qs + r * 136 + c16 + 8 * q) = qo; *(LAS u32x4*)(Ks + r * 136 + c16 + 8 * q) = ko;
            const unsigned vw[4] = {vq.x, vq.y, vq.z, vq.w};
#pragma unroll
            for (int i = 0; i < 4; ++i) { const int cc = c16 + 8 * q + 2 * i; VT[cc * 72 + r] = (bf16_t)(vw[i] & 0xffffu); VT[(cc + 1) * 72 + r] = (bf16_t)(vw[i] >> 16); }
        }
        { const u32x4* sp = (const u32x4*)(ST + (size_t)u * 16384);
#pragma unroll
            for (int i = 0; i < 4; ++i) { const int idx = tid + 512 * i; *(LAS u32x4*)(Ss + (idx >> 4) * 136 + (idx & 15) * 8) = sp[idx]; } }
        __syncthreads();
        const int tt = w & 1, dvt = w >> 1;
        f32x16 o = zero16();
#pragma unroll
        for (int ks = 0; ks < 8; ++ks) {
            const bf16x8 a = *(const LAS bf16x8*)(Ss + (dvt * 32 + r32) * 136 + ks * 16 + hh * 8);
            const bf16x8 b = *(const LAS bf16x8*)(Qs + (tt * 32 + r32) * 136 + ks * 16 + hh * 8);
            o = mfma32(a, b, o);
        }
#pragma unroll
        for (int st = 0; st < 2; ++st) {
            if (st <= tt) {
                f32x16 pp = zero16();
#pragma unroll
                for (int ks = 0; ks < 8; ++ks) {
                    const bf16x8 a = *(const LAS bf16x8*)(Ks + (st * 32 + r32) * 136 + ks * 16 + hh * 8);
                    const bf16x8 b = *(const LAS bf16x8*)(Qs + (tt * 32 + r32) * 136 + ks * 16 + hh * 8);
                    pp = mfma32(a, b, pp);
                }
                if (st == tt) {
#pragma unroll
                    for (int reg = 0; reg < 16; ++reg) { const int sl = (reg & 3) + 8 * (reg >> 2) + 4 * hh; if (sl > r32) pp[reg] = 0.f; }
                }
#pragma unroll
                for (int s2 = 0; s2 < 2; ++s2) {
                    u32x4 pb; pb.x = pk2(pp[8 * s2 + 0], pp[8 * s2 + 1]); pb.y = pk2(pp[8 * s2 + 2], pp[8 * s2 + 3]); pb.z = pk2(pp[8 * s2 + 4], pp[8 * s2 + 5]); pb.w = pk2(pp[8 * s2 + 6], pp[8 * s2 + 7]);
                    const LAS bf16_t* vp = VT + (dvt * 32 + r32) * 72 + st * 32 + 16 * s2 + 4 * hh;
                    const u32x2 va = *(const LAS u32x2*)vp, vb = *(const LAS u32x2*)(vp + 8);
                    u32x4 av; av.x = va.x; av.y = va.y; av.z = vb.x; av.w = vb.y;
                    o = mfma32(__builtin_bit_cast(bf16x8, av), __builtin_bit_cast(bf16x8, pb), o);
                }
            }
        }
        float ss = 0.f;
#pragma unroll
        for (int reg = 0; reg < 16; ++reg) ss += o[reg] * o[reg];
        ss += __shfl_xor(ss, 32);
        if (hh == 0) red[(tt * 32 + r32) * 4 + dvt] = ss;
        __syncthreads();
        { const int t = tt * 32 + r32; const f32x4 rr = *(const LAS f32x4*)(red + t * 4); const float rsn = rsqrtf(((rr[0] + rr[1]) + (rr[2] + rr[3])) * (1.f / 128.f) + EPS);
            if (t < hu.L) {
                const bf16_t* gp = GG + (size_t)(lrow0 + t) * D + hu.h * 128; bf16_t* op = O2 + (size_t)(hu.row0 + t) * D + hu.h * 128;
#pragma unroll
                for (int g4 = 0; g4 < 4; ++g4) { const int dv = dvt * 32 + 8 * g4 + 4 * hh;
                    const u32x2 gv = *(const u32x2*)(gp + dv); const f32x4 gw = *(const f32x4*)(gnorm + hu.h * 128 + dv);
                    u32x2 ov; ov.x = pk2(o[4 * g4 + 0] * rsn * gw[0] * bflo(gv.x), o[4 * g4 + 1] * rsn * gw[1] * bfhi(gv.x));
                    ov.y = pk2(o[4 * g4 + 2] * rsn * gw[2] * bflo(gv.y), o[4 * g4 + 3] * rsn * gw[3] * bfhi(gv.y));
                    *(u32x2*)(op + dv) = ov; }
            } }
        __syncthreads();
    }
}

__device__ __forceinline__ void attn_phase(LAS unsigned char* lds, KP p) {
    const int tid = o_tid(), lane = tid & 63, w = tid >> 6, r32 = lane & 31, hh = lane >> 5;
    LAS bf16_t* Ks = (LAS bf16_t*)lds; LAS bf16_t* VT = Ks + 192 * 72;
    const bf16_t* Kb = (const bf16_t*)(p->ws + WS_KB); const bf16_t* Vb = (const bf16_t*)(p->ws + WS_VB); const bf16_t* Qb = (const bf16_t*)(p->ws + WS_QB);
    bf16_t* O = (bf16_t*)(p->ws + WS_O);
    const float* sinks = p->in[18];
    const int bidx = o_bid(), gdim = o_grid();
    for (int u = bidx; u < 2048 + 64; u += gdim) {
        int qrow0, krow0, nk, kvh, L, sb = -1;
        if (u < 2048) { const int b = u >> 9, c = (u >> 2) & 127; kvh = u & 3; const int c0 = c < 2 ? 0 : c - 2; qrow0 = b * TP + 64 * c; krow0 = b * TP + 64 * c0; nk = (c - c0 + 1) * 64; L = 64; }
        else { const int uu = u - 2048; sb = uu >> 2; kvh = uu & 3; qrow0 = MP + 32 * sb; krow0 = qrow0 - 128; nk = 160; L = 32; }
        for (int idx = tid; idx < nk * 8; idx += 512) { const int s = idx >> 3, p8 = (idx & 7) * 8;
            u32x4 kq, vq;
            if (sb >= 0 && s < 128) { const float* kp = p->in[3] + ((size_t)(sb * 128 + s) * 4 + kvh) * 64 + p8; const float* vp = p->in[4] + ((size_t)(sb * 128 + s) * 4 + kvh) * 64 + p8;
                kq = pack8(*(const f32x4*)kp, *(const f32x4*)(kp + 4)); vq = pack8(*(const f32x4*)vp, *(const f32x4*)(vp + 4)); }
            else { kq = *(const u32x4*)(Kb + (size_t)(krow0 + s) * 256 + kvh * 64 + p8); vq = *(const u32x4*)(Vb + (size_t)(krow0 + s) * 256 + kvh * 64 + p8); }
            *(LAS u32x4*)(Ks + s * 72 + p8) = kq;
            const unsigned vw[4] = {vq.x, vq.y, vq.z, vq.w};
#pragma unroll
            for (int i = 0; i < 4; ++i) { VT[(p8 + 2 * i) * 200 + s] = (bf16_t)(vw[i] & 0xffffu); VT[(p8 + 2 * i + 1) * 200 + s] = (bf16_t)(vw[i] >> 16); }
        }
        __syncthreads();
        const int g = w >> 1, tt = w & 1, qh = kvh * 4 + g, nst = nk >> 5;
        if (tt * 32 < L) {
            const int t = tt * 32 + r32;
            bf16x8 qf[4];
#pragma unroll
            for (int ks = 0; ks < 4; ++ks) qf[ks] = *(const bf16x8*)(Qb + (size_t)(qrow0 + t) * D + qh * 64 + ks * 16 + hh * 8);
            f32x16 pp[6];
            const float sink = sinks[qh];
            float mx = sink;
#pragma unroll
            for (int st = 0; st < 6; ++st) {
                pp[st] = zero16();
                if (st < nst) {
#pragma unroll
                    for (int ks = 0; ks < 4; ++ks) pp[st] = mfma32(*(const LAS bf16x8*)(Ks + (st * 32 + r32) * 72 + ks * 16 + hh * 8), qf[ks], pp[st]);
#pragma unroll
                    for (int reg = 0; reg < 16; ++reg) mx = fmaxf(mx, pp[st][reg]);
                }
            }
            mx = fmaxf(mx, __shfl_xor(mx, 32));
            float sum = 0.f;
#pragma unroll
            for (int st = 0; st < 6; ++st) if (st < nst) {
#pragma unroll
                for (int reg = 0; reg < 16; ++reg) { const float e = __expf(pp[st][reg] - mx); pp[st][reg] = e; sum += e; } }
            sum += __shfl_xor(sum, 32);
            const float inv = frcp(sum + __expf(sink - mx));
            f32x16 o0 = zero16(), o1 = zero16();
#pragma unroll
            for (int st = 0; st < 6; ++st) if (st < nst) {
#pragma unroll
                for (int s2 = 0; s2 < 2; ++s2) {
                    u32x4 pb; pb.x = pk2(pp[st][8 * s2 + 0], pp[st][8 * s2 + 1]); pb.y = pk2(pp[st][8 * s2 + 2], pp[st][8 * s2 + 3]); pb.z = pk2(pp[st][8 * s2 + 4], pp[st][8 * s2 + 5]); pb.w = pk2(pp[st][8 * s2 + 6], pp[st][8 * s2 + 7]);
                    const bf16x8 pbv = __builtin_bit_cast(bf16x8, pb);
                    { const LAS bf16_t* vp = VT + r32 * 200 + st * 32 + 16 * s2 + 4 * hh; const u32x2 va = *(const LAS u32x2*)vp, vb = *(const LAS u32x2*)(vp + 8);
                      u32x4 av; av.x = va.x; av.y = va.y; av.z = vb.x; av.w = vb.y; o0 = mfma32(__builtin_bit_cast(bf16x8, av), pbv, o0); }
                    { const LAS bf16_t* vp = VT + (32 + r32) * 200 + st * 32 + 16 * s2 + 4 * hh; const u32x2 va = *(const LAS u32x2*)vp, vb = *(const LAS u32x2*)(vp + 8);
                      u32x4 av; av.x = va.x; av.y = va.y; av.z = vb.x; av.w = vb.y; o1 = mfma32(__builtin_bit_cast(bf16x8, av), pbv, o1); }
                }
            }
            bf16_t* op = O + (size_t)(qrow0 + t) * D + qh * 64;
#pragma unroll
            for (int g4 = 0; g4 < 4; ++g4) { const int dv = 8 * g4 + 4 * hh;
                u32x2 a; a.x = pk2(o0[4 * g4] * inv, o0[4 * g4 + 1] * inv); a.y = pk2(o0[4 * g4 + 2] * inv, o0[4 * g4 + 3] * inv); *(u32x2*)(op + dv) = a;
                u32x2 b; b.x = pk2(o1[4 * g4] * inv, o1[4 * g4 + 1] * inv); b.y = pk2(o1[4 * g4 + 2] * inv, o1[4 * g4 + 3] * inv); *(u32x2*)(op + 32 + dv) = b; }
        }
        __syncthreads();
    }
}

template <int MODE, bool LAST>
__device__ __forceinline__ void x_phase(KP p, const float* wpost) {
    const int tid = o_tid(), lane = tid & 63, wave = tid >> 6;
    const int gw = o_bid() * 8 + wave, NGW = o_grid() * 8;
    const bf16_t* MIX = (const bf16_t*)(p->ws + WS_MIX); const float* SSQ = (const float*)(p->ws + WS_SSQ);
    bf16_t* XB = (bf16_t*)(p->ws + WS_XB); float* RS = (float*)(p->ws + WS_RS);
    f32x4 wv[4];
#pragma unroll
    for (int j = 0; j < 4; ++j) wv[j] = *((const f32x4*)wpost + lane + 64 * j);
    for (int row0 = gw; row0 < MT; row0 += 2 * NGW) {
        f32x4 v[2][4]; u32x2 mm[2][4]; float tot[2]; bool ok[2];
#pragma unroll
        for (int q = 0; q < 2; ++q) { const int row = row0 + q * NGW; ok[q] = row < MT; const int rr = ok[q] ? row : row0;
            const float sq = SSQ[(size_t)rr * 16 + (lane & 15)];
            tot[q] = sq;
            const u32x2* mr = (const u32x2*)(MIX + (size_t)rr * D) + lane;
#pragma unroll
            for (int j = 0; j < 4; ++j) mm[q][j] = mr[64 * j];
            if (MODE == 0) { const f32x4* xr = (const f32x4*)xrow_ptr(p, rr) + lane;
#pragma unroll
                for (int j = 0; j < 4; ++j) v[q][j] = xr[64 * j]; }
            else { const u32x2* xr = (const u32x2*)(XB + (size_t)rr * D) + lane;
#pragma unroll
                for (int j = 0; j < 4; ++j) { const u32x2 xx = xr[64 * j]; v[q][j] = (f32x4){bflo(xx.x), bfhi(xx.x), bflo(xx.y), bfhi(xx.y)}; } }
        }
#pragma unroll
        for (int q = 0; q < 2; ++q) { const int row = row0 + q * NGW;
            float t = tot[q]; t += __shfl_xor(t, 1); t += __shfl_xor(t, 2); t += __shfl_xor(t, 4); t += __shfl_xor(t, 8);
            const float rsm = rsqrtf(t * (1.f / D) + EPS);
            float s = 0.f;
#pragma unroll
            for (int j = 0; j < 4; ++j) { const u32x2 m2 = mm[q][j];
                v[q][j][0] += bflo(m2.x) * rsm * wv[j][0]; v[q][j][1] += bfhi(m2.x) * rsm * wv[j][1]; v[q][j][2] += bflo(m2.y) * rsm * wv[j][2]; v[q][j][3] += bfhi(m2.y) * rsm * wv[j][3];
                s += (v[q][j][0] * v[q][j][0] + v[q][j][1] * v[q][j][1]) + (v[q][j][2] * v[q][j][2] + v[q][j][3] * v[q][j][3]); }
            if (ok[q]) {
                if (LAST) { f32x4* o = (f32x4*)(p->out + OUT_Y + (size_t)row * D) + lane;
#pragma unroll
                    for (int j = 0; j < 4; ++j) o[64 * j] = v[q][j];
                } else {
                    u32x2* ob = (u32x2*)(XB + (size_t)row * D) + lane;
#pragma unroll
                    for (int j = 0; j < 4; ++j) { u32x2 wb; wb.x = pk2(v[q][j][0], v[q][j][1]); wb.y = pk2(v[q][j][2], v[q][j][3]); ob[64 * j] = wb; }
                    s = wave_sum(s);
                    if (lane == 0) RS[row] = rsqrtf(s * (1.f / D) + EPS);
                }
            }
        }
    }
}

constexpr int NPHASE = 21;
__global__ void __launch_bounds__(512, 2) mega(Params p_arg, int ph_lo, int ph_hi) {
    extern __shared__ __attribute__((aligned(16))) unsigned char lds_raw[];
    LAS unsigned char* lds = (LAS unsigned char*)lds_raw;
    cg::grid_group grid = cg::this_grid();
#define G o_grid()
#define bid o_bid()
#define p kparams()
#define ws (kparams()->ws)
#ifndef PHMASK
#define PHMASK 0x1fffff
#endif
#define IN(k) (((PHMASK >> (k)) & 1) && ph_lo <= (k) && (k) < ph_hi)
#define SEAM(k) do { if (IN((k) + 1)) grid.sync(); else __syncthreads(); } while (0)
    if (IN(0)) { p0_prologue(lds, p); SEAM(0); }
#pragma unroll 1
    for (int hf = 0; hf < 2; ++hf) {
        const int rowbase = hf ? 16384 : 0, rows = hf ? 16896 : 16384, pb = 1 + 4 * hf;
        if (IN(pb)) {
            pg8::Gemm g{(const bf16_t*)(ws + WS_XB) + (size_t)rowbase * D, (const bf16_t*)(ws + WS_W1), rows, 4096, 1024}; pg8::StaticOrder S; S.init(rows, 4096, G, bid);
            Epi1 E{ws, rowbase};
            pg8::gemm_phase<Epi1>(lds, g, S, E); SEAM(pb);
        }
        if (IN(pb + 1)) { h1_phase(lds, p, hf); SEAM(pb + 1); }
        if (IN(pb + 2)) { h2_phase(p, hf); SEAM(pb + 2); }
        if (IN(pb + 3)) { h3_phase(lds, p, hf); SEAM(pb + 3); }
    }
    if (IN(9)) {
        pg8::Gemm g{(const bf16_t*)(ws + WS_XB), (const bf16_t*)(ws + WS_W2), MT, 1024, 1024}; pg8::StaticOrder S; S.init(MT, 1024, G, bid);
        Epi2 E{ws}; pg8::gemm_phase<Epi2>(lds, g, S, E); SEAM(9);
    }
    if (IN(10)) { x_phase<0, false>(p, p->in[6]); SEAM(10); }
#pragma unroll 1
    for (int ly = 0; ly < 2; ++ly) {
        const int pb = ly ? 18 : 11;
        if (IN(pb)) {
            pg8::Gemm g{(const bf16_t*)(ws + WS_XB), (const bf16_t*)(ws + (ly ? WS_W7 : WS_W3)), MT, 2 * DFF, 1024}; pg8::StaticOrder S; S.init(MT, 2 * DFF, G, bid);
            Epi3 E{ws}; pg8::gemm_phase<Epi3>(lds, g, S, E); SEAM(pb);
        }
        if (IN(pb + 1)) {
            pg8::Gemm g{(const bf16_t*)(ws + WS_H), (const bf16_t*)(ws + (ly ? WS_W8 : WS_W4)), MT, 1024, DFF}; pg8::StaticOrder S; S.init(MT, 1024, G, bid);
            Epi2 E{ws}; pg8::gemm_phase<Epi2>(lds, g, S, E); SEAM(pb + 1);
        }
        if (ly == 0) {
            if (IN(13)) { x_phase<1, false>(p, p->in[8]); SEAM(13); }
            if (IN(14)) {
                pg8::Gemm g{(const bf16_t*)(ws + WS_XB), (const bf16_t*)(ws + WS_W5), MT, 1536, 1024}; pg8::StaticOrder S; S.init(MT, 1536, G, bid);
                Epi5 E{ws, p->out};
                pg8::gemm_phase<Epi5>(lds, g, S, E); SEAM(14);
            }
            if (IN(15)) { attn_phase(lds, p); SEAM(15); }
            if (IN(16)) {
                pg8::Gemm g{(const bf16_t*)(ws + WS_O), (const bf16_t*)(ws + WS_W6), MT, 1024, 1024}; pg8::StaticOrder S; S.init(MT, 1024, G, bid);
                Epi2 E{ws}; pg8::gemm_phase<Epi2>(lds, g, S, E); SEAM(16);
            }
            if (IN(17)) { x_phase<1, false>(p, p->in[6] + D); SEAM(17); }
        }
    }
    if (IN(20)) { x_phase<1, true>(p, p->in[8] + D); }
#undef IN
#undef SEAM
#undef p
#undef ws
#undef G
#undef bid
}

extern "C" void kernel_launch(void* const* d_in, const int* in_sizes, int n_in, void* d_out, int out_size, void* d_ws, size_t ws_size, hipStream_t stream) {
    static int grid = 0;
    if (!grid) {
        if (n_in != 20 || ws_size < WS_END) { fprintf(stderr, "kernel_launch: unexpected n_in %d / ws_size %zu (need %zu)\n", n_in, ws_size, (size_t)WS_END); return; }
        int dev = 0, cus = 0, per_cu = 0;
        hipGetDevice(&dev); hipDeviceGetAttribute(&cus, hipDeviceAttributeMultiprocessorCount, dev);
        hipFuncSetAttribute((const void*)mega, hipFuncAttributeMaxDynamicSharedMemorySize, LDS_BYTES);
        hipOccupancyMaxActiveBlocksPerMultiprocessor(&per_cu, (const void*)mega, 512, LDS_BYTES);
        if (per_cu < 1) { fprintf(stderr, "kernel_launch: occupancy query says %d blocks per CU\n", per_cu); per_cu = 1; }
        grid = cus * 1;
    }
    Params p{};
    for (int i = 0; i < 20; ++i) p.in[i] = (const float*)d_in[i];
    p.out = (float*)d_out; p.ws = (unsigned char*)d_ws;
#if MK_ONE_LAUNCH
    int lo = 0, hi = NPHASE;
    void* args[] = {&p, &lo, &hi};
    hipError_t e = hipLaunchCooperativeKernel((const void*)mega, dim3(grid), dim3(512), args, LDS_BYTES, stream);
    if (e != hipSuccess) fprintf(stderr, "cooperative launch failed: %s (grid %d)\n", hipGetErrorString(e), grid);
#else
    for (int ph = 0; ph < NPHASE; ++ph) { hipLaunchKernelGGL(mega, dim3(grid), dim3(512), LDS_BYTES, stream, p, ph, ph + 1);
        if ((PROBE_DUP >> ph) & 1) for (int r = 0; r < PROBE_REP; ++r) hipLaunchKernelGGL(mega, dim3(grid), dim3(512), LDS_BYTES, stream, p, ph, ph + 1); }
#endif
}
```

```cpp
#include <hip/hip_runtime.h>
#include <hip/hip_cooperative_groups.h>
#include <cstdio>
#include <cstdint>
namespace cg = cooperative_groups;

#ifndef PROBE_DUP
#define PROBE_DUP 0
#define PROBE_REP 1
#endif
#ifndef MK_ONE_LAUNCH
#define MK_ONE_LAUNCH 1
#endif

#define LAS __attribute__((address_space(3)))
typedef unsigned short bf16_t;
typedef short bf16x8 __attribute__((ext_vector_type(8)));
typedef float f32x4 __attribute__((ext_vector_type(4)));
typedef float f32x2 __attribute__((ext_vector_type(2)));
typedef float f32x16 __attribute__((ext_vector_type(16)));
typedef unsigned u32x4 __attribute__((ext_vector_type(4)));
typedef unsigned u32x2 __attribute__((ext_vector_type(2)));

constexpr int D = 1024, TP = 8192, MP = 32768, MS = 512, MT = MP + MS, DFF = 2816;
constexpr float EPS = 1e-6f;
constexpr int XCD_BAR_WORDS_C = 3456;
constexpr size_t MiB = 1u << 20;
constexpr size_t WS_W1 = 0, WS_W2 = 8 * MiB, WS_W3 = 10 * MiB, WS_W4 = 21 * MiB, WS_W5 = 27 * MiB, WS_W6 = 30 * MiB, WS_W7 = 32 * MiB, WS_W8 = 43 * MiB;
constexpr size_t WS_ROPE = 49 * MiB, WS_RS = 51 * MiB, WS_LB = 51 * MiB + 512 * 1024, WS_SSQ = 52 * MiB;
constexpr size_t WS_BAR = 55 * MiB, BAR_BYTES = XCD_BAR_WORDS_C * 4;
constexpr size_t WS_XB = 56 * MiB, WS_O = 121 * MiB, WS_ST = 121 * MiB;
constexpr size_t WS_BIG = 251 * MiB;
constexpr size_t WS_QH = WS_BIG, WS_KK = WS_BIG + 33 * MiB, WS_VV = WS_BIG + 66 * MiB, WS_GG = WS_BIG + 99 * MiB, WS_BB = WS_BIG + 132 * MiB;
constexpr size_t WS_MIX = WS_BIG, WS_H = WS_BIG + 65 * MiB;
constexpr size_t WS_KB = WS_BIG + 65 * MiB, WS_VB = WS_BIG + 82 * MiB, WS_QB = WS_BIG + 99 * MiB;
constexpr size_t WS_END = WS_BIG + 244 * MiB;
constexpr size_t OUT_Y = 0, OUT_STP = 34078720, OUT_STS = 34603008, OUT_CKP = 36700160, OUT_CVP = 36831232, OUT_CKS = 36962304, OUT_CVS = 37486592;

constexpr int LDS_BYTES = 131072 + 16;

struct Params { const float* in[20]; float* out; unsigned char* ws; };
typedef const Params __attribute__((address_space(4)))* KP;
__device__ __forceinline__ KP kparams() { KP k = (KP)__builtin_amdgcn_kernarg_segment_ptr(); asm volatile("" : "+s"(k)); return k; }

__device__ __forceinline__ unsigned pk2(float lo, float hi) { unsigned r; asm("v_cvt_pk_bf16_f32 %0, %1, %2" : "=v"(r) : "v"(lo), "v"(hi)); return r; }
__device__ __forceinline__ float bflo(unsigned u) { return __uint_as_float(u << 16); }
__device__ __forceinline__ float bfhi(unsigned u) { return __uint_as_float(u & 0xffff0000u); }
__device__ __forceinline__ float frcp(float x) { return __builtin_amdgcn_rcpf(x); }
__device__ __forceinline__ float siluf(float v) { float c = fminf(fmaxf(v, -30.f), 30.f); return v * frcp(1.f + __expf(-c)); }
__device__ __forceinline__ float wave_sum(float v) {
#pragma unroll
    for (int o = 1; o < 64; o <<= 1) v += __shfl_xor(v, o);
    return v;
}
#define LDS_WAIT() asm volatile("s_waitcnt lgkmcnt(0)" ::: "memory")
__device__ __forceinline__ int o_tid() { int t = threadIdx.x; asm volatile("" : "+v"(t)); return t; }
__device__ __forceinline__ int o_bid() { int t = blockIdx.x; asm volatile("" : "+s"(t)); return t; }
__device__ __forceinline__ int o_grid() { int t = gridDim.x; asm volatile("" : "+s"(t)); return t; }

namespace pg8 {
constexpr int BM = 256, BK = 64, HALF = 128, HTB = HALF * BK * 2, STAGE_BYTES = 8 * HTB, NXCD = 8, WGM = 8;
__host__ __device__ __forceinline__ int lds_byte(int r, int c) { const int st = (r >> 4) * 2 + (c >> 5), rr = r & 15, cc = c & 31, ob = rr * 64 + cc * 2; return st * 1024 + (ob ^ (((ob >> 9) & 1) << 5)); }
__host__ __device__ __forceinline__ void stage_rc(int b, int& R, int& C) { const int st = b / 1024, sb = b % 1024, swz = sb ^ (((sb >> 9) & 1) << 5); R = (st >> 1) * 16 + swz / 64; C = (st & 1) * 32 + (swz % 64) / 2; }
__host__ __device__ __forceinline__ int perm32(int rho) { const int n = rho >> 4, i = rho & 15; return 8 * (i >> 2) + 4 * n + (i & 3); }
struct Unit { int pm, pn; };
struct Gemm { const bf16_t* A; const bf16_t* Bt; int M, N, K; };
struct StaticOrder {
    int nM, nN, nwg, G, c;
    __device__ void init(int M, int N, int G_, int c_) { nM = M / BM; nN = N / BM; nwg = nM * nN; G = G_; c = c_; }
    __device__ bool next(int i, Unit& u) const {
        const long L = (long)i * G + c; if (L >= nwg) return false;
        int wgid = (int)L; { const int q = nwg / NXCD, r = nwg % NXCD, xcd = wgid % NXCD, off = wgid / NXCD; wgid = (xcd < r ? xcd * (q + 1) : r * (q + 1) + (xcd - r) * q) + off; }
        const int nig = WGM * nN, gid = wgid / nig, fm = gid * WGM, gsz = (nM - fm) < WGM ? (nM - fm) : WGM;
        u.pm = fm + ((wgid % nig) % gsz); u.pn = (wgid % nig) / gsz; return true;
    }
};
template <class Epi>
__device__ __forceinline__ void gemm_phase(LAS unsigned char* lds, const Gemm g, const StaticOrder& S, const Epi& E) {
    const int tid = o_tid(), wid = __builtin_amdgcn_readfirstlane(tid >> 6), lane = tid & 63, wr = wid >> 2, wc = wid & 3, fr = lane & 15, fq = lane >> 4;
    const int K = g.K, nt = K / BK;
    unsigned voffA[2], voffB[2];
#pragma unroll
    for (int i = 0; i < 2; ++i) { int R, C; stage_rc(tid * 16 + i * 8192, R, C); const int Rb = (R & ~31) + perm32(R & 31);
        voffA[i] = (unsigned)(R * K + C) * 2u; voffB[i] = (unsigned)(Rb * K + C) * 2u; }
    const size_t kstep = (size_t)(BK * 2);
    const size_t hstep = (size_t)HALF * K * 2;
    const size_t tstep = 2 * hstep;
    const unsigned ldsw = (unsigned)wid * 1024u;
    const int aoff = lds_byte(wr * 64 + fr, fq * 8), boff = lds_byte(wc * 32 + fr, fq * 8);
#define PG8_SA(b, h) (((b) * 2 + (h)) * HTB)
#define PG8_SB(b, h) ((4 + (b) * 2 + (h)) * HTB)
#define PG8_STAGE(bufoff, gbase, voff) do { _Pragma("unroll") for (int _i = 0; _i < 2; ++_i) \
        __builtin_amdgcn_global_load_lds((const unsigned*)((const char*)(gbase) + (voff)[_i]), (LAS unsigned*)(lds + (bufoff) + ldsw + _i * 8192), 16, 0, 0); } while (0)
#define PG8_LDA(dst, b, h) do { _Pragma("unroll") for (int m = 0; m < 4; ++m) _Pragma("unroll") for (int k = 0; k < 2; ++k) dst[m][k] = *(const LAS bf16x8*)(lds + PG8_SA(b, h) + aoff + m * 2048 + k * 1024); } while (0)
#define PG8_LDB(dst, b, h) do { _Pragma("unroll") for (int n = 0; n < 2; ++n) _Pragma("unroll") for (int k = 0; k < 2; ++k) dst[n][k] = *(const LAS bf16x8*)(lds + PG8_SB(b, h) + boff + n * 2048 + k * 1024); } while (0)
#define PG8_MMA(ai, bj, At, Bt) do { __builtin_amdgcn_s_setprio(1); _Pragma("unroll") for (int m = 0; m < 4; ++m) _Pragma("unroll") for (int n = 0; n < 2; ++n) _Pragma("unroll") for (int k = 0; k < 2; ++k) \
        acc[ai][bj][m][n] = __builtin_amdgcn_mfma_f32_16x16x32_bf16(Bt[n][k], At[m][k], acc[ai][bj][m][n], 0, 0, 0); __builtin_amdgcn_s_setprio(0); } while (0)
#define PG8_WAIT_V(n) asm volatile("s_waitcnt vmcnt(" #n ")" ::: "memory")
#define PG8_WAIT_L(n) asm volatile("s_waitcnt lgkmcnt(" #n ")" ::: "memory")
#define PG8_BAR __builtin_amdgcn_s_barrier()
#define PG8_SCHED __builtin_amdgcn_sched_barrier(0)
    Unit cur, nxt; int ui = 0;
    if (!S.next(0, cur)) return;
    f32x4 acc[2][2][4][2];
#pragma unroll
    for (int a = 0; a < 2; ++a)
#pragma unroll
        for (int b = 0; b < 2; ++b)
#pragma unroll
            for (int m = 0; m < 4; ++m)
#pragma unroll
                for (int n = 0; n < 2; ++n) acc[a][b][m][n] = (f32x4){0.f, 0.f, 0.f, 0.f};
    bf16x8 At[4][2], B0[2][2], B1[2][2];
    const char* cA = (const char*)g.A + (size_t)cur.pm * tstep; const char* cB = (const char*)g.Bt + (size_t)cur.pn * tstep;
    PG8_STAGE(PG8_SB(0, 0), cB, voffB); PG8_STAGE(PG8_SB(0, 1), cB + hstep, voffB); PG8_STAGE(PG8_SA(0, 0), cA, voffA); PG8_STAGE(PG8_SA(0, 1), cA + hstep, voffA);
    if (wr == 1) PG8_BAR;
    PG8_WAIT_V(2); PG8_BAR;
    PG8_STAGE(PG8_SB(1, 0), cB + kstep, voffB); PG8_STAGE(PG8_SA(1, 0), cA + kstep, voffA); PG8_STAGE(PG8_SB(1, 1), cB + hstep + kstep, voffB);
    PG8_WAIT_V(6); PG8_BAR;
    for (;;) {
        const bool has_next = S.next(ui + 1, nxt);
        const char* nA = has_next ? (const char*)g.A + (size_t)nxt.pm * tstep : cA; const char* nB = has_next ? (const char*)g.Bt + (size_t)nxt.pn * tstep : cB;
        for (int t = 0; t < nt; t += 2) {
            const bool last = (t == nt - 2);
            const char* a1 = cA + (size_t)(t + 1) * kstep;
            const char* a2 = last ? nA : cA + (size_t)(t + 2) * kstep; const char* b2 = last ? nB : cB + (size_t)(t + 2) * kstep;
            const char* a3 = a2 + kstep; const char* b3 = b2 + kstep;
            PG8_LDB(B0, 0, 0); PG8_LDB(B1, 0, 1); PG8_SCHED; PG8_LDA(At, 0, 0); PG8_STAGE(PG8_SA(1, 1), a1 + hstep, voffA);
            PG8_WAIT_V(8); PG8_WAIT_L(0); PG8_BAR; PG8_MMA(0, 0, At, B0); PG8_MMA(0, 1, At, B1); PG8_BAR; PG8_SCHED;
            PG8_LDA(At, 0, 1); PG8_STAGE(PG8_SB(0, 0), b2, voffB); PG8_STAGE(PG8_SB(0, 1), b2 + hstep, voffB); PG8_STAGE(PG8_SA(0, 0), a2, voffA);
            PG8_WAIT_V(8); PG8_WAIT_L(0); PG8_BAR; PG8_MMA(1, 0, At, B0); PG8_MMA(1, 1, At, B1); PG8_BAR; PG8_SCHED;
            PG8_LDB(B0, 1, 0); PG8_LDB(B1, 1, 1); PG8_SCHED; PG8_LDA(At, 1, 0); PG8_STAGE(PG8_SA(0, 1), a2 + hstep, voffA);
            PG8_WAIT_V(8); PG8_WAIT_L(0); PG8_BAR; PG8_MMA(0, 0, At, B0); PG8_MMA(0, 1, At, B1); PG8_BAR; PG8_SCHED;
            PG8_LDA(At, 1, 1); PG8_STAGE(PG8_SB(1, 0), b3, voffB); PG8_STAGE(PG8_SB(1, 1), b3 + hstep, voffB); PG8_STAGE(PG8_SA(1, 0), a3, voffA);
            PG8_WAIT_V(8); PG8_WAIT_L(0); PG8_BAR; PG8_MMA(1, 0, At, B0); PG8_MMA(1, 1, At, B1); PG8_BAR; PG8_SCHED;
        }
        if (wr == 0) PG8_BAR;
        E(acc, cur, wr, wc, fr, fq);
        if (!has_next) break;
#pragma unroll
        for (int a = 0; a < 2; ++a)
#pragma unroll
            for (int b = 0; b < 2; ++b)
#pragma unroll
                for (int m = 0; m < 4; ++m)
#pragma unroll
                    for (int n = 0; n < 2; ++n) acc[a][b][m][n] = (f32x4){0.f, 0.f, 0.f, 0.f};
        cur = nxt; cA = nA; cB = nB; ++ui;
        if (wr == 1) PG8_BAR;
    }
    PG8_WAIT_V(0);
    PG8_BAR;
#undef PG8_SA
#undef PG8_SB
#undef PG8_STAGE
#undef PG8_LDA
#undef PG8_LDB
#undef PG8_MMA
#undef PG8_WAIT_V
#undef PG8_WAIT_L
#undef PG8_BAR
#undef PG8_SCHED
}
}
using pg8::Unit;

__device__ __forceinline__ u32x4 pack8(const f32x4 a, const f32x4 b) { u32x4 o; o.x = pk2(a[0], a[1]); o.y = pk2(a[2], a[3]); o.z = pk2(b[0], b[1]); o.w = pk2(b[2], b[3]); return o; }

struct Epi1 {
    unsigned char* ws; int rowbase;
    __device__ __forceinline__ void operator()(f32x4 (&acc)[2][2][4][2], const Unit& u, int wr, int wc, int fr, int fq) const {
        bf16_t* KK = (bf16_t*)(ws + WS_KK); float* BB = (float*)(ws + WS_BB); const float* RS = (const float*)(ws + WS_RS); const float* LB = (const float*)(ws + WS_LB);
        const int type = u.pn >> 2, cs = (u.pn & 3) * 256 + wc * 32 + fq * 8;
        int lrow0 = u.pm * 256 + wr * 64 + fr; asm volatile("" : "+v"(lrow0));
#pragma unroll
        for (int ai = 0; ai < 2; ++ai)
#pragma unroll
            for (int m = 0; m < 4; ++m) { const float rs = RS[rowbase + lrow0 + ai * 128 + m * 16];
#pragma unroll
                for (int bj = 0; bj < 2; ++bj)
#pragma unroll
                    for (int n = 0; n < 2; ++n) acc[ai][bj][m][n] *= rs; }
        if (type != 1) {
            bf16_t* O = (bf16_t*)(ws + WS_QH + (size_t)(type == 0 ? 0 : (type == 2 ? 66 : 99)) * MiB);
#pragma unroll
            for (int ai = 0; ai < 2; ++ai)
#pragma unroll
                for (int m = 0; m < 4; ++m) { bf16_t* rowp = O + (size_t)(lrow0 + ai * 128 + m * 16) * D + cs;
#pragma unroll
                    for (int bj = 0; bj < 2; ++bj) { f32x4 v0 = acc[ai][bj][m][0], v1 = acc[ai][bj][m][1];
                        if (type != 2) {
#pragma unroll
                            for (int j = 0; j < 4; ++j) { v0[j] = siluf(v0[j]); v1[j] = siluf(v1[j]); } }
                        *(u32x4*)(rowp + bj * 128) = pack8(v0, v1); } }
        } else {
            const bool smp = (rowbase + u.pm * 256) >= MP;
#pragma unroll
            for (int bj = 0; bj < 2; ++bj) {
                const f32x4 lb0 = *(const f32x4*)(LB + cs + bj * 128), lb1 = *(const f32x4*)(LB + cs + bj * 128 + 4);
#pragma unroll
                for (int ai = 0; ai < 2; ++ai)
#pragma unroll
                    for (int m = 0; m < 4; ++m) {
                        f32x4 k0, k1;
#pragma unroll
                        for (int j = 0; j < 4; ++j) {
                            { const float v = fminf(fmaxf(acc[ai][bj][m][0][j], -30.f), 30.f); const float kk = (1.f - lb0[j]) * frcp(1.f + __expf(v)); k0[j] = kk; acc[ai][bj][m][0][j] = __logf(1.f - kk); }
                            { const float v = fminf(fmaxf(acc[ai][bj][m][1][j], -30.f), 30.f); const float kk = (1.f - lb1[j]) * frcp(1.f + __expf(v)); k1[j] = kk; acc[ai][bj][m][1][j] = __logf(1.f - kk); }
                        }
                        *(u32x4*)(KK + (size_t)(lrow0 + ai * 128 + m * 16) * D + cs + bj * 128) = pack8(k0, k1);
                    }
            }
#pragma unroll
            for (int ai = 0; ai < 2; ++ai)
#pragma unroll
                for (int bj = 0; bj < 2; ++bj)
#pragma unroll
                    for (int n = 0; n < 2; ++n)
#pragma unroll
                        for (int j = 0; j < 4; ++j) {
                            float v[4], tot[4];
#pragma unroll
                            for (int m = 0; m < 4; ++m) { float x = acc[ai][bj][m][n][j];
#pragma unroll
                                for (int d = 1; d < 16; d <<= 1) { const float t = __shfl_up(x, d, 16); if (fr >= d) x += t; }
                                v[m] = x; tot[m] = __shfl(x, 15, 16); }
                            if (!smp) { v[1] += tot[0]; v[2] += tot[0] + tot[1]; v[3] += (tot[0] + tot[1]) + tot[2]; }
                            else { v[1] += tot[0]; v[3] += tot[2]; }
#pragma unroll
                            for (int m = 0; m < 4; ++m) acc[ai][bj][m][n][j] = v[m];
                        }
#pragma unroll
            for (int ai = 0; ai < 2; ++ai)
#pragma unroll
                for (int m = 0; m < 4; ++m) { float* rowp = BB + (size_t)(lrow0 + ai * 128 + m * 16) * D + cs;
#pragma unroll
                    for (int bj = 0; bj < 2; ++bj) { *(f32x4*)(rowp + bj * 128) = acc[ai][bj][m][0]; *(f32x4*)(rowp + bj * 128 + 4) = acc[ai][bj][m][1]; } }
        }
    }
};
struct Epi2 {
    unsigned char* ws;
    __device__ __forceinline__ void operator()(f32x4 (&acc)[2][2][4][2], const Unit& u, int wr, int wc, int fr, int fq) const {
        bf16_t* MIX = (bf16_t*)(ws + WS_MIX); float* SSQ = (float*)(ws + WS_SSQ); asm volatile("" : "+v"(fr));
#pragma unroll
        for (int ai = 0; ai < 2; ++ai)
#pragma unroll
            for (int m = 0; m < 4; ++m) { const int row = u.pm * 256 + ai * 128 + wr * 64 + m * 16 + fr; float ss = 0.f;
                bf16_t* rowp = MIX + (size_t)row * D + u.pn * 256 + wc * 32 + fq * 8;
#pragma unroll
                for (int bj = 0; bj < 2; ++bj) { const f32x4 v0 = acc[ai][bj][m][0], v1 = acc[ai][bj][m][1];
#pragma unroll
                    for (int j = 0; j < 4; ++j) ss += v0[j] * v0[j] + v1[j] * v1[j];
                    *(u32x4*)(rowp + bj * 128) = pack8(v0, v1); }
                ss += __shfl_xor(ss, 16); ss += __shfl_xor(ss, 32);
                if (fq == 0) SSQ[(size_t)row * 16 + u.pn * 4 + wc] = ss; }
    }
};
struct Epi3 {
    unsigned char* ws;
    __device__ __forceinline__ void operator()(f32x4 (&acc)[2][2][4][2], const Unit& u, int wr, int wc, int fr, int fq) const {
        bf16_t* H = (bf16_t*)(ws + WS_H); const float* RS = (const float*)(ws + WS_RS); asm volatile("" : "+v"(fr));
#pragma unroll
        for (int ai = 0; ai < 2; ++ai)
#pragma unroll
            for (int m = 0; m < 4; ++m) { const int row = u.pm * 256 + ai * 128 + wr * 64 + m * 16 + fr; const float rs = RS[row];
                f32x4 h0, h1;
#pragma unroll
                for (int j = 0; j < 4; ++j) { h0[j] = siluf(acc[ai][0][m][0][j] * rs) * (acc[ai][1][m][0][j] * rs); h1[j] = siluf(acc[ai][0][m][1][j] * rs) * (acc[ai][1][m][1][j] * rs); }
                *(u32x4*)(H + (size_t)row * DFF + u.pn * 128 + wc * 32 + fq * 8) = pack8(h0, h1); }
    }
};
struct Epi5 {
    unsigned char* ws; float* out;
    __device__ __forceinline__ void operator()(f32x4 (&acc)[2][2][4][2], const Unit& u, int wr, int wc, int fr, int fq) const {
        bf16_t* Qb = (bf16_t*)(ws + WS_QB); const float* RS = (const float*)(ws + WS_RS); const float* ROPE = (const float*)(ws + WS_ROPE); asm volatile("" : "+v"(fr));
        const int d1 = fq * 8;
#pragma unroll
        for (int ai = 0; ai < 2; ++ai)
#pragma unroll
            for (int m = 0; m < 4; ++m) { const int row = u.pm * 256 + ai * 128 + wr * 64 + m * 16 + fr; const float rs = RS[row];
                int pos, crow, cb; bool smp = row >= MP;
                if (!smp) { const int t = row & (TP - 1); pos = t; cb = row >> 13; crow = t - (TP - 128); }
                else { const int lr = row - MP; const int t = lr & 31; pos = 2048 + t; cb = lr >> 5; crow = 96 + t; }
                f32x4 x1a = acc[ai][0][m][0] * rs, x1b = acc[ai][0][m][1] * rs, x2a = acc[ai][1][m][0] * rs, x2b = acc[ai][1][m][1] * rs;
                if (u.pn != 1) {
                    const f32x4* rp = (const f32x4*)(ROPE + ((size_t)pos * 32 + d1) * 2);
                    const f32x4 r0 = rp[0], r1 = rp[1], r2 = rp[2], r3 = rp[3];
                    f32x4 ca = {r0[0], r0[2], r1[0], r1[2]}, sa = {r0[1], r0[3], r1[1], r1[3]}, cb4 = {r2[0], r2[2], r3[0], r3[2]}, sb4 = {r2[1], r2[3], r3[1], r3[3]};
                    const f32x4 o1a = x1a * ca - x2a * sa, o2a = x2a * ca + x1a * sa, o1b = x1b * cb4 - x2b * sb4, o2b = x2b * cb4 + x1b * sb4;
                    x1a = o1a; x2a = o2a; x1b = o1b; x2b = o2b;
                }
                if (u.pn >= 2) {
                    const int hq = (u.pn - 2) * 4 + wc; bf16_t* q = Qb + (size_t)row * D + hq * 64 + d1;
                    *(u32x4*)q = pack8(x1a * 0.125f, x1b * 0.125f); *(u32x4*)(q + 32) = pack8(x2a * 0.125f, x2b * 0.125f);
                } else {
                    bf16_t* kb = (bf16_t*)(ws + WS_KB + (size_t)(u.pn == 0 ? 0 : 17) * MiB) + (size_t)row * 256 + wc * 64 + d1;
                    *(u32x4*)kb = pack8(x1a, x1b); *(u32x4*)(kb + 32) = pack8(x2a, x2b);
                    if (crow >= 0) {
                        float* co = out + (smp ? (u.pn == 0 ? OUT_CKS : OUT_CVS) : (u.pn == 0 ? OUT_CKP : OUT_CVP)) + ((size_t)(cb * 128 + crow) * 4 + wc) * 64 + d1;
                        *(f32x4*)co = x1a; *(f32x4*)(co + 4) = x1b; *(f32x4*)(co + 32) = x2a; *(f32x4*)(co + 36) = x2b;
                    }
                }
            }
    }
};

__device__ __forceinline__ void tr_item(const float* W, int ldw, int col0, const float* fold, bf16_t* WT, int K, int drow0, int k0, LAS float* scr, int lane) {
    float wreg[32];
#pragma unroll
    for (int i = 0; i < 32; ++i) { const int kk = 2 * i + (lane >> 5); wreg[i] = W[(size_t)(k0 + kk) * ldw + col0 + (lane & 31)]; }
    if (fold) {
#pragma unroll
        for (int i = 0; i < 32; ++i) wreg[i] *= fold[k0 + 2 * i + (lane >> 5)]; }
#pragma unroll
    for (int i = 0; i < 32; ++i) scr[(2 * i + (lane >> 5)) * 33 + (lane & 31)] = wreg[i];
    LDS_WAIT();
    const int c = lane & 7;
#pragma unroll
    for (int j = 0; j < 4; ++j) { const int n = (lane >> 3) + 8 * j; const LAS float* s = scr + (8 * c) * 33 + n;
        u32x4 o; o.x = pk2(s[0 * 33], s[1 * 33]); o.y = pk2(s[2 * 33], s[3 * 33]); o.z = pk2(s[4 * 33], s[5 * 33]); o.w = pk2(s[6 * 33], s[7 * 33]);
        *(u32x4*)(WT + (size_t)(drow0 + n) * K + k0 + 8 * c) = o; }
    LDS_WAIT();
}
__device__ __forceinline__ const float* xrow_ptr(KP p, int row) { return row < MP ? p->in[0] + (size_t)row * D : p->in[1] + (size_t)(row - MP) * D; }

__device__ __forceinline__ void p0_prologue(LAS unsigned char* lds, KP p) {
    const int tid = o_tid(), lane = tid & 63, wave = tid >> 6;
    LAS float* scr = (LAS float*)(lds + wave * 16384);
    const int bidx = o_bid(), gdim = o_grid();
    const int gw = bidx * 8 + wave, NGW = gdim * 8;
    unsigned char* ws = p->ws;
    constexpr int I1 = 16 * 128, I2 = 16 * 32, I3 = 16 * 176, I4 = 44 * 32, I5 = 16 * 48, I6 = 16 * 32, I7 = I3, I8 = I4;
    constexpr int NIT = I1 + I2 + I3 + I4 + I5 + I6 + I7 + I8;
    for (int it = gw; it < NIT; it += NGW) {
        int r = it;
        if (r < I1) { const int nb = r % 128, kb = r / 128; tr_item(p->in[11], 4096, 32 * nb, p->in[5], (bf16_t*)(ws + WS_W1), 1024, 32 * nb, 64 * kb, scr, lane); continue; } r -= I1;
        if (r < I2) { const int nb = r % 32, kb = r / 32; tr_item(p->in[14], 1024, 32 * nb, nullptr, (bf16_t*)(ws + WS_W2), 1024, 32 * nb, 64 * kb, scr, lane); continue; } r -= I2;
        if (r < I3) { const int nb = r % 176, kb = r / 176; const int rho = 32 * nb, col = ((rho >> 7) & 1) * DFF + 128 * (rho >> 8) + (rho & 127);
            tr_item(p->in[9], 2 * DFF, col, p->in[7], (bf16_t*)(ws + WS_W3), 1024, rho, 64 * kb, scr, lane); continue; } r -= I3;
        if (r < I4) { const int nb = r % 32, kb = r / 32; tr_item(p->in[10], 1024, 32 * nb, nullptr, (bf16_t*)(ws + WS_W4), DFF, 32 * nb, 64 * kb, scr, lane); continue; } r -= I4;
        if (r < I5) { const int nb = r % 48, kb = r / 48; const int rho = 32 * nb, cc = 256 * (rho >> 8) + 64 * ((rho & 127) >> 5) + 32 * ((rho >> 7) & 1);
            if (cc < 512) tr_item(p->in[16], 512, cc, p->in[15], (bf16_t*)(ws + WS_W5), 1024, rho, 64 * kb, scr, lane);
            else tr_item(p->in[17], 1024, cc - 512, p->in[5] + D, (bf16_t*)(ws + WS_W5), 1024, rho, 64 * kb, scr, lane);
            continue; } r -= I5;
        if (r < I6) { const int nb = r % 32, kb = r / 32; tr_item(p->in[19], 1024, 32 * nb, nullptr, (bf16_t*)(ws + WS_W6), 1024, 32 * nb, 64 * kb, scr, lane); continue; } r -= I6;
        if (r < I7) { const int nb = r % 176, kb = r / 176; const int rho = 32 * nb, col = ((rho >> 7) & 1) * DFF + 128 * (rho >> 8) + (rho & 127);
            tr_item(p->in[9] + (size_t)D * 2 * DFF, 2 * DFF, col, p->in[7] + D, (bf16_t*)(ws + WS_W7), 1024, rho, 64 * kb, scr, lane); continue; } r -= I7;
        { const int nb = r % 32, kb = r / 32; tr_item(p->in[10] + (size_t)DFF * D, 1024, 32 * nb, nullptr, (bf16_t*)(ws + WS_W8), DFF, 32 * nb, 64 * kb, scr, lane); }
    }
    bf16_t* XB = (bf16_t*)(ws + WS_XB); float* RS = (float*)(ws + WS_RS);
    for (int row0 = gw; row0 < MT; row0 += 4 * NGW) {
        f32x4 v[4][4];
#pragma unroll
        for (int q = 0; q < 4; ++q) { const int row = row0 + q * NGW; const f32x4* xr = (const f32x4*)xrow_ptr(p, row < MT ? row : row0) + lane;
#pragma unroll
            for (int j = 0; j < 4; ++j) v[q][j] = xr[64 * j]; }
#pragma unroll
        for (int q = 0; q < 4; ++q) { const int row = row0 + q * NGW; float s = 0.f;
#pragma unroll
            for (int j = 0; j < 4; ++j) s += (v[q][j][0] * v[q][j][0] + v[q][j][1] * v[q][j][1]) + (v[q][j][2] * v[q][j][2] + v[q][j][3] * v[q][j][3]);
            s = wave_sum(s);
            if (row < MT) { u32x2* o = (u32x2*)(XB + (size_t)row * D) + lane;
#pragma unroll
                for (int j = 0; j < 4; ++j) { u32x2 w; w.x = pk2(v[q][j][0], v[q][j][1]); w.y = pk2(v[q][j][2], v[q][j][3]); o[64 * j] = w; }
                if (lane == 0) RS[row] = rsqrtf(s * (1.f / D) + EPS); }
        }
    }
    const int gt = bidx * 512 + tid, NGT = gdim * 512;
    float* ROPE = (float*)(ws + WS_ROPE);
    for (int i = gt; i < TP * 32; i += NGT) { const int pos = i >> 5, d = i & 31;
        const float inv = exp2f(-(float)d * (13.287712379549449f / 32.f));
        const float ang = (float)pos * inv;
        double rev = (double)ang * 0.15915494309189535; rev -= __builtin_rint(rev);
        const float rr = (float)rev;
        ROPE[2 * i] = __builtin_amdgcn_cosf(rr); ROPE[2 * i + 1] = __builtin_amdgcn_sinf(rr); }
    float* LB = (float*)(ws + WS_LB);
    for (int i = gt; i < D; i += NGT) { const float a0 = p->in[12][i], a1 = p->in[12][D + i]; LB[i] = 1.f / (1.f + expf(a1 - a0)); }
    for (int i = gt; i < 16 * 96 * 64; i += NGT) { const int b = i / (96 * 64), rem = i % (96 * 64);
        const f32x4 kv = *((const f32x4*)(p->in[3] + (size_t)b * 32768 + 32 * 256) + rem), vv = *((const f32x4*)(p->in[4] + (size_t)b * 32768 + 32 * 256) + rem);
        *((f32x4*)(p->out + OUT_CKS + (size_t)b * 32768) + rem) = kv; *((f32x4*)(p->out + OUT_CVS + (size_t)b * 32768) + rem) = vv; }
}

__device__ __forceinline__ f32x16 mfma32(bf16x8 a, bf16x8 b, f32x16 c) { return __builtin_amdgcn_mfma_f32_32x32x16_bf16(a, b, c, 0, 0, 0); }
__device__ __forceinline__ f32x16 zero16() { f32x16 z; for (int i = 0; i < 16; ++i) z[i] = 0.f; return z; }

struct HUnit { int row0, L, h, sb; };
__device__ __forceinline__ HUnit hunit(int u, int hf) { HUnit r;
    if (u < 2048) { r.row0 = (2 * hf + (u >> 10)) * TP + 64 * ((u >> 3) & 127); r.L = 64; r.h = u & 7; r.sb = -1; }
    else { const int uu = u - 2048; r.sb = uu >> 3; r.h = uu & 7; r.row0 = MP + 32 * r.sb; r.L = 32; }
    return r; }

__device__ __forceinline__ void h1_phase(LAS unsigned char* lds, KP p, int hf) {
    const int tid = o_tid(), lane = tid & 63, w = tid >> 6, r32 = lane & 31, hh = lane >> 5;
    LAS bf16_t* KT = (LAS bf16_t*)lds; LAS bf16_t* VT = KT + 128 * 72;
    const int nunits = hf ? 2176 : 2048, rowbase = hf ? 16384 : 0;
    const float* BB = (const float*)(p->ws + WS_BB); const bf16_t* KK = (const bf16_t*)(p->ws + WS_KK); const bf16_t* VV = (const bf16_t*)(p->ws + WS_VV);
    bf16_t* ST = (bf16_t*)(p->ws + WS_ST);
    const int r = tid >> 3, c16 = (tid & 7) * 16;
    const int bidx = o_bid(), gdim = o_grid();
    for (int u = bidx; u < nunits; u += gdim) {
        const HUnit hu = hunit(u, hf); const int lrow0 = hu.row0 - rowbase;
        const size_t off = (size_t)(lrow0 + r) * D + hu.h * 128 + c16, offl = (size_t)(lrow0 + hu.L - 1) * D + hu.h * 128 + c16;
        const bool valid = r < hu.L;
#pragma unroll
        for (int q = 0; q < 2; ++q) {
            u32x4 kq = {0u, 0u, 0u, 0u}, vq = {0u, 0u, 0u, 0u}; f32x4 b0 = {0, 0, 0, 0}, b1 = b0, l0 = b0, l1 = b0;
            if (valid) { kq = *(const u32x4*)(KK + off + 8 * q); vq = *(const u32x4*)(VV + off + 8 * q);
                b0 = *(const f32x4*)(BB + off + 8 * q); b1 = *(const f32x4*)(BB + off + 8 * q + 4); l0 = *(const f32x4*)(BB + offl + 8 * q); l1 = *(const f32x4*)(BB + offl + 8 * q + 4); }
            float kt[8];
            kt[0] = bflo(kq.x) * __expf(l0[0] - b0[0]); kt[1] = bfhi(kq.x) * __expf(l0[1] - b0[1]); kt[2] = bflo(kq.y) * __expf(l0[2] - b0[2]); kt[3] = bfhi(kq.y) * __expf(l0[3] - b0[3]);
            kt[4] = bflo(kq.z) * __expf(l1[0] - b1[0]); kt[5] = bfhi(kq.z) * __expf(l1[1] - b1[1]); kt[6] = bflo(kq.w) * __expf(l1[2] - b1[2]); kt[7] = bfhi(kq.w) * __expf(l1[3] - b1[3]);
            const unsigned vw[4] = {vq.x, vq.y, vq.z, vq.w};
#pragma unroll
            for (int i = 0; i < 4; ++i) { const unsigned pk = pk2(kt[2 * i], kt[2 * i + 1]); const int cc = c16 + 8 * q + 2 * i;
                KT[cc * 72 + r] = (bf16_t)(pk & 0xffffu); KT[(cc + 1) * 72 + r] = (bf16_t)(pk >> 16);
                VT[cc * 72 + r] = (bf16_t)(vw[i] & 0xffffu); VT[(cc + 1) * 72 + r] = (bf16_t)(vw[i] >> 16); }
        }
        __syncthreads();
        const int dvt = w >> 1, dk0 = (w & 1) * 2;
        f32x16 acc0 = zero16(), acc1 = zero16();
#pragma unroll
        for (int ks = 0; ks < 4; ++ks) {
            const bf16x8 a = *(const LAS bf16x8*)(VT + (dvt * 32 + r32) * 72 + ks * 16 + hh * 8);
            const bf16x8 bq0 = *(const LAS bf16x8*)(KT + (dk0 * 32 + r32) * 72 + ks * 16 + hh * 8);
            const bf16x8 bq1 = *(const LAS bf16x8*)(KT + ((dk0 + 1) * 32 + r32) * 72 + ks * 16 + hh * 8);
            acc0 = mfma32(a, bq0, acc0); acc1 = mfma32(a, bq1, acc1);
        }
        bf16_t* st = ST + (size_t)u * 16384;
        if (hu.L == 64) {
#pragma unroll
            for (int reg = 0; reg < 16; ++reg) { const int dv = dvt * 32 + (reg & 3) + 8 * (reg >> 2) + 4 * hh;
                st[dv * 128 + dk0 * 32 + r32] = (bf16_t)(pk2(acc0[reg], 0.f) & 0xffffu); st[dv * 128 + (dk0 + 1) * 32 + r32] = (bf16_t)(pk2(acc1[reg], 0.f) & 0xffffu); }
        } else {
            const float* s0p = p->in[2] + (size_t)(hu.sb * 8 + hu.h) * 16384; float* sop = p->out + OUT_STS + (size_t)(hu.sb * 8 + hu.h) * 16384;
            const float* bl = BB + (size_t)(lrow0 + 31) * D + hu.h * 128;
#pragma unroll
            for (int jt = 0; jt < 2; ++jt) { const int dk = (dk0 + jt) * 32 + r32; const float dec = __expf(bl[dk]);
#pragma unroll
                for (int reg = 0; reg < 16; ++reg) { const int dv = dvt * 32 + (reg & 3) + 8 * (reg >> 2) + 4 * hh;
                    const float s0 = s0p[dk * 128 + dv]; const float a = jt ? acc1[reg] : acc0[reg];
                    sop[dk * 128 + dv] = dec * s0 + a; st[dv * 128 + dk] = (bf16_t)(pk2(s0, 0.f) & 0xffffu); } }
        }
        __syncthreads();
    }
}
__device__ __forceinline__ void h2_phase(KP p, int hf) {
    const int tid = o_tid(); const int bidx = o_bid(), gdim = o_grid();
    const float* BB = (const float*)(p->ws + WS_BB); unsigned* ST = (unsigned*)(p->ws + WS_ST);
    for (int it = bidx * 512 + tid; it < 16 * 8192; it += gdim * 512) {
        const int pair = it >> 13, e = it & 8191, dv = e >> 6, dk = (e & 63) * 2, bl = pair >> 3, h = pair & 7;
        float s0 = 0.f, s1 = 0.f;
        unsigned* sp = ST + ((size_t)(bl * 1024 + h) * 16384 + dv * 128 + dk) / 2;
        const float* bp = BB + (size_t)(bl * TP + 63) * D + h * 128 + dk;
        for (int c0 = 0; c0 < 128; c0 += 8) {
            unsigned uu[8]; f32x2 dd[8];
#pragma unroll
            for (int i = 0; i < 8; ++i) { uu[i] = sp[(size_t)(c0 + i) * 65536]; dd[i] = *(const f32x2*)(bp + (size_t)(c0 + i) * 64 * D); }
#pragma unroll
            for (int i = 0; i < 8; ++i) { sp[(size_t)(c0 + i) * 65536] = pk2(s0, s1); s0 = __expf(dd[i][0]) * s0 + bflo(uu[i]); s1 = __expf(dd[i][1]) * s1 + bfhi(uu[i]); }
        }
        float* so = p->out + OUT_STP + (size_t)((2 * hf + bl) * 8 + h) * 16384;
        so[dk * 128 + dv] = s0; so[(dk + 1) * 128 + dv] = s1;
    }
}
__device__ __forceinline__ void h3_phase(LAS unsigned char* lds, KP p, int hf) {
    const int tid = o_tid(), lane = tid & 63, w = tid >> 6, r32 = lane & 31, hh = lane >> 5;
    LAS bf16_t* Qs = (LAS bf16_t*)lds; LAS bf16_t* Ks = Qs + 64 * 136; LAS bf16_t* VT = Ks + 64 * 136; LAS bf16_t* Ss = VT + 128 * 72; LAS float* red = (LAS float*)(Ss + 128 * 136);
    const int nunits = hf ? 2176 : 2048, rowbase = hf ? 16384 : 0;
    const float* BB = (const float*)(p->ws + WS_BB); const bf16_t* KK = (const bf16_t*)(p->ws + WS_KK); const bf16_t* VV = (const bf16_t*)(p->ws + WS_VV);
    const bf16_t* QH = (const bf16_t*)(p->ws + WS_QH); const bf16_t* GG = (const bf16_t*)(p->ws + WS_GG);
    const bf16_t* ST = (const bf16_t*)(p->ws + WS_ST); bf16_t* O2 = (bf16_t*)(p->ws + WS_XB);
    const float* gnorm = p->in[13];
    const int r = tid >> 3, c16 = (tid & 7) * 16;
    const int bidx = o_bid(), gdim = o_grid();
    for (int u = bidx; u < nunits; u += gdim) {
        const HUnit hu = hunit(u, hf); const int lrow0 = hu.row0 - rowbase;
        const size_t off = (size_t)(lrow0 + r) * D + hu.h * 128 + c16;
        const bool valid = r < hu.L;
#pragma unroll
        for (int q = 0; q < 2; ++q) {
            u32x4 kq = {0u, 0u, 0u, 0u}, vq = kq, qq = kq; f32x4 b0 = {0, 0, 0, 0}, b1 = b0;
            if (valid) { kq = *(const u32x4*)(KK + off + 8 * q); vq = *(const u32x4*)(VV + off + 8 * q); qq = *(const u32x4*)(QH + off + 8 * q);
                b0 = *(const f32x4*)(BB + off + 8 * q); b1 = *(const f32x4*)(BB + off + 8 * q + 4); }
            float eb[8], kf[8], qf[8];
#pragma unroll
            for (int j = 0; j < 4; ++j) { eb[j] = __expf(b0[j]); eb[4 + j] = __expf(b1[j]); }
            kf[0] = bflo(kq.x); kf[1] = bfhi(kq.x); kf[2] = bflo(kq.y); kf[3] = bfhi(kq.y); kf[4] = bflo(kq.z); kf[5] = bfhi(kq.z); kf[6] = bflo(kq.w); kf[7] = bfhi(kq.w);
            qf[0] = bflo(qq.x); qf[1] = bfhi(qq.x); qf[2] = bflo(qq.y); qf[3] = bfhi(qq.y); qf[4] = bflo(qq.z); qf[5] = bfhi(qq.z); qf[6] = bflo(qq.w); qf[7] = bfhi(qq.w);
            u32x4 qo, ko;
            qo.x = pk2(qf[0] * eb[0], qf[1] * eb[1]); qo.y = pk2(qf[2] * eb[2], qf[3] * eb[3]); qo.z = pk2(qf[4] * eb[4], qf[5] * eb[5]); qo.w = pk2(qf[6] * eb[6], qf[7] * eb[7]);
            ko.x = pk2(kf[0] * frcp(eb[0]), kf[1] * frcp(eb[1])); ko.y = pk2(kf[2] * frcp(eb[2]), kf[3] * frcp(eb[3])); ko.z = pk2(kf[4] * frcp(eb[4]), kf[5] * frcp(eb[5])); ko.w = pk2(kf[6] * frcp(eb[6]), kf[7] * frcp(eb[7]));
            *(LAS u32x4*)(Qs + r * 136 + c16 + 8 * q) = qo; *(LAS u32x4*)(Ks + r * 136 + c16 + 8 * q) = ko;
            const unsigned vw[4] = {vq.x, vq.y, vq.z, vq.w};
#pragma unroll
            for (int i = 0; i < 4; ++i) { const int cc = c16 + 8 * q + 2 * i; VT[cc * 72 + r] = (bf16_t)(vw[i] & 0xffffu); VT[(cc + 1) * 72 + r] = (bf16_t)(vw[i] >> 16); }
        }
        { const u32x4* sp = (const u32x4*)(ST + (size_t)u * 16384);
#pragma unroll
            for (int i = 0; i < 4; ++i) { const int idx = tid + 512 * i; *(LAS u32x4*)(Ss + (idx >> 4) * 136 + (idx & 15) * 8) = sp[idx]; } }
        __syncthreads();
        const int tt = w & 1, dvt = w >> 1;
        f32x16 o = zero16();
#pragma unroll
        for (int ks = 0; ks < 8; ++ks) {
            const bf16x8 a = *(const LAS bf16x8*)(Ss + (dvt * 32 + r32) * 136 + ks * 16 + hh * 8);
            const bf16x8 b = *(const LAS bf16x8*)(Qs + (tt * 32 + r32) * 136 + ks * 16 + hh * 8);
            o = mfma32(a, b, o);
        }
#pragma unroll
        for (int st = 0; st < 2; ++st) {
            if (st <= tt) {
                f32x16 pp = zero16();
#pragma unroll
                for (int ks = 0; ks < 8; ++ks) {
                    const bf16x8 a = *(const LAS bf16x8*)(Ks + (st * 32 + r32) * 136 + ks * 16 + hh * 8);
                    const bf16x8 b = *(const LAS bf16x8*)(Qs + (tt * 32 + r32) * 136 + ks * 16 + hh * 8);
                    pp = mfma32(a, b, pp);
                }
                if (st == tt) {
#pragma unroll
                    for (int reg = 0; reg < 16; ++reg) { const int sl = (reg & 3) + 8 * (reg >> 2) + 4 * hh; if (sl > r32) pp[reg] = 0.f; }
                }
#pragma unroll
                for (int s2 = 0; s2 < 2; ++s2) {
                    u32x4 pb; pb.x = pk2(pp[8 * s2 + 0], pp[8 * s2 + 1]); pb.y = pk2(pp[8 * s2 + 2], pp[8 * s2 + 3]); pb.z = pk2(pp[8 * s2 + 4], pp[8 * s2 + 5]); pb.w = pk2(pp[8 * s2 + 6], pp[8 * s2 + 7]);
                    const LAS bf16_t* vp = VT + (dvt * 32 + r32) * 72 + st * 32 + 16 * s2 + 4 * hh;
                    const u32x2 va = *(const LAS u32x2*)vp, vb = *(const LAS u32x2*)(vp + 8);
                    u32x4 av; av.x = va.x; av.y = va.y; av.z = vb.x; av.w = vb.y;
                    o = mfma32(__builtin_bit_cast(bf16x8, av), __builtin_bit_cast(bf16x8, pb), o);
                }
            }
        }
        float ss = 0.f;
#pragma unroll
        for (int reg = 0; reg < 16; ++reg) ss += o[reg] * o[reg];
        ss += __shfl_xor(ss, 32);
        if (hh == 0) red[(tt * 32 + r32) * 4 + dvt] = ss;
        __syncthreads();
        { const int t = tt * 32 + r32; const f32x4 rr = *(const LAS f32x4*)(red + t * 4); const float rsn = rsqrtf(((rr[0] + rr[1]) + (rr[2] + rr[3])) * (1.f / 128.f) + EPS);
            if (t < hu.L) {
                const bf16_t* gp = GG + (size_t)(lrow0 + t) * D + hu.h * 128; bf16_t* op = O2 + (size_t)(hu.row0 + t) * D + hu.h * 128;
#pragma unroll
                for (int g4 = 0; g4 < 4; ++g4) { const int dv = dvt * 32 + 8 * g4 + 4 * hh;
                    const u32x2 gv = *(const u32x2*)(gp + dv); const f32x4 gw = *(const f32x4*)(gnorm + hu.h * 128 + dv);
                    u32x2 ov; ov.x = pk2(o[4 * g4 + 0] * rsn * gw[0] * bflo(gv.x), o[4 * g4 + 1] * rsn * gw[1] * bfhi(gv.x));
                    ov.y = pk2(o[4 * g4 + 2] * rsn * gw[2] * bflo(gv.y), o[4 * g4 + 3] * rsn * gw[3] * bfhi(gv.y));
                    *(u32x2*)(op + dv) = ov; }
            } }
        __syncthreads();
    }
}

__device__ __forceinline__ void attn_phase(LAS unsigned char* lds, KP p) {
    const int tid = o_tid(), lane = tid & 63, w = tid >> 6, r32 = lane & 31, hh = lane >> 5;
    LAS bf16_t* Ks = (LAS bf16_t*)lds; LAS bf16_t* VT = Ks + 192 * 72;
    const bf16_t* Kb = (const bf16_t*)(p->ws + WS_KB); const bf16_t* Vb = (const bf16_t*)(p->ws + WS_VB); const bf16_t* Qb = (const bf16_t*)(p->ws + WS_QB);
    bf16_t* O = (bf16_t*)(p->ws + WS_O);
    const float* sinks = p->in[18];
    const int bidx = o_bid(), gdim = o_grid();
    for (int u = bidx; u < 2048 + 64; u += gdim) {
        int qrow0, krow0, nk, kvh, L, sb = -1;
        if (u < 2048) { const int b = u >> 9, c = (u >> 2) & 127; kvh = u & 3; const int c0 = c < 2 ? 0 : c - 2; qrow0 = b * TP + 64 * c; krow0 = b * TP + 64 * c0; nk = (c - c0 + 1) * 64; L = 64; }
        else { const int uu = u - 2048; sb = uu >> 2; kvh = uu & 3; qrow0 = MP + 32 * sb; krow0 = qrow0 - 128; nk = 160; L = 32; }
        for (int idx = tid; idx < nk * 8; idx += 512) { const int s = idx >> 3, p8 = (idx & 7) * 8;
            u32x4 kq, vq;
            if (sb >= 0 && s < 128) { const float* kp = p->in[3] + ((size_t)(sb * 128 + s) * 4 + kvh) * 64 + p8; const float* vp = p->in[4] + ((size_t)(sb * 128 + s) * 4 + kvh) * 64 + p8;
                kq = pack8(*(const f32x4*)kp, *(const f32x4*)(kp + 4)); vq = pack8(*(const f32x4*)vp, *(const f32x4*)(vp + 4)); }
            else { kq = *(const u32x4*)(Kb + (size_t)(krow0 + s) * 256 + kvh * 64 + p8); vq = *(const u32x4*)(Vb + (size_t)(krow0 + s) * 256 + kvh * 64 + p8); }
            *(LAS u32x4*)(Ks + s * 72 + p8) = kq;
            const unsigned vw[4] = {vq.x, vq.y, vq.z, vq.w};
#pragma unroll
            for (int i = 0; i < 4; ++i) { VT[(p8 + 2 * i) * 200 + s] = (bf16_t)(vw[i] & 0xffffu); VT[(p8 + 2 * i + 1) * 200 + s] = (bf16_t)(vw[i] >> 16); }
        }
        __syncthreads();
        const int g = w >> 1, tt = w & 1, qh = kvh * 4 + g, nst = nk >> 5;
        if (tt * 32 < L) {
            const int t = tt * 32 + r32;
            bf16x8 qf[4];
#pragma unroll
            for (int ks = 0; ks < 4; ++ks) qf[ks] = *(const bf16x8*)(Qb + (size_t)(qrow0 + t) * D + qh * 64 + ks * 16 + hh * 8);
            f32x16 pp[6];
            const float sink = sinks[qh];
            float mx = sink;
#pragma unroll
            for (int st = 0; st < 6; ++st) {
                pp[st] = zero16();
                if (st < nst) {
#pragma unroll
                    for (int ks = 0; ks < 4; ++ks) pp[st] = mfma32(*(const LAS bf16x8*)(Ks + (st * 32 + r32) * 72 + ks * 16 + hh * 8), qf[ks], pp[st]);
#pragma unroll
                    for (int reg = 0; reg < 16; ++reg) mx = fmaxf(mx, pp[st][reg]);
                }
            }
            mx = fmaxf(mx, __shfl_xor(mx, 32));
            float sum = 0.f;
#pragma unroll
            for (int st = 0; st < 6; ++st) if (st < nst) {
#pragma unroll
                for (int reg = 0; reg < 16; ++reg) { const float e = __expf(pp[st][reg] - mx); pp[st][reg] = e; sum += e; } }
            sum += __shfl_xor(sum, 32);
            const float inv = frcp(sum + __expf(sink - mx));
            f32x16 o0 = zero16(), o1 = zero16();
#pragma unroll
            for (int st = 0; st < 6; ++st) if (st < nst) {
#pragma unroll
                for (int s2 = 0; s2 < 2; ++s2) {
                    u32x4 pb; pb.x = pk2(pp[st][8 * s2 + 0], pp[st][8 * s2 + 1]); pb.y = pk2(pp[st][8 * s2 + 2], pp[st][8 * s2 + 3]); pb.z = pk2(pp[st][8 * s2 + 4], pp[st][8 * s2 + 5]); pb.w = pk2(pp[st][8 * s2 + 6], pp[st][8 * s2 + 7]);
                    const bf16x8 pbv = __builtin_bit_cast(bf16x8, pb);
                    { const LAS bf16_t* vp = VT + r32 * 200 + st * 32 + 16 * s2 + 4 * hh; const u32x2 va = *(const LAS u32x2*)vp, vb = *(const LAS u32x2*)(vp + 8);
                      u32x4 av; av.x = va.x; av.y = va.y; av.z = vb.x; av.w = vb.y; o0 = mfma32(__builtin_bit_cast(bf16x8, av), pbv, o0); }
                    { const LAS bf16_t* vp = VT + (32 + r32) * 200 + st * 32 + 16 * s2 + 4 * hh; const u32x2 va = *(const LAS u32x2*)vp, vb = *(const LAS u32x2*)(vp + 8);
                      u32x4 av; av.x = va.x; av.y = va.y; av.z = vb.x; av.w = vb.y; o1 = mfma32(__builtin_bit_cast(bf16x8, av), pbv, o1); }
                }
            }
            bf16_t* op = O + (size_t)(qrow0 + t) * D + qh * 64;
#pragma unroll
            for (int g4 = 0; g4 < 4; ++g4) { const int dv = 8 * g4 + 4 * hh;
                u32x2 a; a.x = pk2(o0[4 * g4] * inv, o0[4 * g4 + 1] * inv); a.y = pk2(o0[4 * g4 + 2] * inv, o0[4 * g4 + 3] * inv); *(u32x2*)(op + dv) = a;
                u32x2 b; b.x = pk2(o1[4 * g4] * inv, o1[4 * g4 + 1] * inv); b.y = pk2(o1[4 * g4 + 2] * inv, o1[4 * g4 + 3] * inv); *(u32x2*)(op + 32 + dv) = b; }
        }
        __syncthreads();
    }
}

constexpr int XR = 4;
template <int MODE, bool LAST>
__device__ __forceinline__ void x_phase(KP p, const float* wpost) {
    const int tid = o_tid(), lane = tid & 63, wave = tid >> 6;
    const int gw = o_bid() * 8 + wave, NGW = o_grid() * 8;
    const bf16_t* MIX = (const bf16_t*)(p->ws + WS_MIX); const float* SSQ = (const float*)(p->ws + WS_SSQ);
    bf16_t* XB = (bf16_t*)(p->ws + WS_XB); float* RS = (float*)(p->ws + WS_RS);
    f32x4 wv[4];
#pragma unroll
    for (int j = 0; j < 4; ++j) wv[j] = *((const f32x4*)wpost + lane + 64 * j);
    for (int row0 = gw; row0 < MT; row0 += XR * NGW) {
        f32x4 v[XR][4]; u32x2 mm[XR][4]; float tot[XR]; bool ok[XR];
#pragma unroll
        for (int q = 0; q < XR; ++q) { const int row = row0 + q * NGW; ok[q] = row < MT; const int rr = ok[q] ? row : row0;
            const float sq = SSQ[(size_t)rr * 16 + (lane & 15)];
            tot[q] = sq;
            const u32x2* mr = (const u32x2*)(MIX + (size_t)rr * D) + lane;
#pragma unroll
            for (int j = 0; j < 4; ++j) mm[q][j] = mr[64 * j];
            if (MODE == 0) { const f32x4* xr = (const f32x4*)xrow_ptr(p, rr) + lane;
#pragma unroll
                for (int j = 0; j < 4; ++j) v[q][j] = xr[64 * j]; }
            else { const u32x2* xr = (const u32x2*)(XB + (size_t)rr * D) + lane;
#pragma unroll
                for (int j = 0; j < 4; ++j) { const u32x2 xx = xr[64 * j]; v[q][j] = (f32x4){bflo(xx.x), bfhi(xx.x), bflo(xx.y), bfhi(xx.y)}; } }
        }
#pragma unroll
        for (int q = 0; q < XR; ++q) { const int row = row0 + q * NGW;
            float t = tot[q]; t += __shfl_xor(t, 1); t += __shfl_xor(t, 2); t += __shfl_xor(t, 4); t += __shfl_xor(t, 8);
            const float rsm = rsqrtf(t * (1.f / D) + EPS);
            float s = 0.f;
#pragma unroll
            for (int j = 0; j < 4; ++j) { const u32x2 m2 = mm[q][j];
                v[q][j][0] += bflo(m2.x) * rsm * wv[j][0]; v[q][j][1] += bfhi(m2.x) * rsm * wv[j][1]; v[q][j][2] += bflo(m2.y) * rsm * wv[j][2]; v[q][j][3] += bfhi(m2.y) * rsm * wv[j][3];
                s += (v[q][j][0] * v[q][j][0] + v[q][j][1] * v[q][j][1]) + (v[q][j][2] * v[q][j][2] + v[q][j][3] * v[q][j][3]); }
            if (ok[q]) {
                if (LAST) { f32x4* o = (f32x4*)(p->out + OUT_Y + (size_t)row * D) + lane;
#pragma unroll
                    for (int j = 0; j < 4; ++j) o[64 * j] = v[q][j];
                } else {
                    u32x2* ob = (u32x2*)(XB + (size_t)row * D) + lane;
#pragma unroll
                    for (int j = 0; j < 4; ++j) { u32x2 wb; wb.x = pk2(v[q][j][0], v[q][j][1]); wb.y = pk2(v[q][j][2], v[q][j][3]); ob[64 * j] = wb; }
                    s = wave_sum(s);
                    if (lane == 0) RS[row] = rsqrtf(s * (1.f / D) + EPS);
                }
            }
        }
    }
}


#define XB_TMO      128
#define XB_XCNT(j)  (256  + 64 * (j))
#define XB_XSUB(j)  (1280 + 64 * (j))
#define XB_XGEN(j)  (2304 + 64 * (j))
#define XB_TOP      3328
#define XB_TOPGEN   3392
#define XCD_BAR_WORDS 3456
#define XB_SPIN_CAP (1u << 20)
__device__ __forceinline__ unsigned xb_ld(unsigned* p)              { return __hip_atomic_load(p, __ATOMIC_RELAXED, __HIP_MEMORY_SCOPE_AGENT); }
__device__ __forceinline__ unsigned xb_add(unsigned* p, unsigned v) { return __hip_atomic_fetch_add(p, v, __ATOMIC_RELAXED, __HIP_MEMORY_SCOPE_AGENT); }
__device__ __forceinline__ unsigned xb_xcc_id() { return (unsigned)__builtin_amdgcn_s_getreg((3 << 11) | 20) & 0xFu; }
#define XB_SPIN(cond, bar) do { unsigned _sp = 0; while (cond) { __builtin_amdgcn_s_sleep(1); \
    if ((++_sp & 255u) == 0u) { if (xb_ld(&(bar)[XB_TMO])) break; if (_sp > XB_SPIN_CAP) { atomicAdd(&(bar)[XB_TMO], 1u); break; } } } } while (0)
struct XcdBarrier { unsigned* bar; unsigned x; volatile LAS unsigned* st; };
__device__ __forceinline__ XcdBarrier xcd_barrier_post(unsigned* bar, volatile LAS unsigned* st) {
    XcdBarrier b; b.bar = bar; b.x = xb_xcc_id(); b.st = st;
    if (threadIdx.x == 0) (void)xb_add(&bar[XB_XCNT(b.x)], 1u);
    return b;
}
__device__ __forceinline__ void xcd_barrier_complete(unsigned* bar, unsigned x, unsigned& nloc, unsigned& nx) {
    const unsigned G = gridDim.x * gridDim.y * gridDim.z;
    unsigned sum, cnt, mine, sp = 0u;
    for (;;) {
        sum = 0u; cnt = 0u; mine = 0u;
#pragma unroll
        for (unsigned j = 0; j < 16; ++j) { const unsigned c = xb_ld(&bar[XB_XCNT(j)]); sum += c; cnt += (c > 0u) ? 1u : 0u; mine = (j == x) ? c : mine; }
        if (sum == G) break;
        __builtin_amdgcn_s_sleep(1);
        if ((++sp & 255u) == 0u) { if (xb_ld(&bar[XB_TMO])) break; if (sp > XB_SPIN_CAP) { atomicAdd(&bar[XB_TMO], 1u); break; } }
    }
    nloc = mine > 0u ? mine : 1u; nx = cnt > 0u ? cnt : 1u;
}
__device__ __forceinline__ void xcd_barrier(const XcdBarrier& b) {
    asm volatile("s_waitcnt vmcnt(0)" ::: "memory");
    __syncthreads();
    if (threadIdx.x == 0) {
        unsigned* bar = b.bar;
        __builtin_amdgcn_s_waitcnt(0);
        unsigned nloc = b.st[0], nx = b.st[1];
        if (nloc == 0u) { xcd_barrier_complete(bar, b.x, nloc, nx); b.st[0] = nloc; b.st[1] = nx; }
        const unsigned old = xb_add(&bar[XB_XSUB(b.x)], 1u);
        const unsigned gen = old / nloc;
        if (old + 1u == (gen + 1u) * nloc) {
            __builtin_amdgcn_fence(__ATOMIC_RELEASE, "agent");
            asm volatile("s_waitcnt vmcnt(0)" ::: "memory");
            const unsigned og = xb_add(&bar[XB_TOP], 1u);
            const unsigned tg = og / nx;
            if (og + 1u == (tg + 1u) * nx) xb_add(&bar[XB_TOPGEN], 1u);
            else XB_SPIN(xb_ld(&bar[XB_TOPGEN]) == tg, bar);
            __builtin_amdgcn_fence(__ATOMIC_ACQUIRE, "agent");
            xb_add(&bar[XB_XGEN(b.x)], 1u);
            asm volatile("s_waitcnt vmcnt(0)" ::: "memory");
        } else {
            XB_SPIN(xb_ld(&bar[XB_XGEN(b.x)]) == gen, bar);
            __builtin_amdgcn_fence(__ATOMIC_ACQUIRE, "agent");
            asm volatile("s_waitcnt vmcnt(0)" ::: "memory");
        }
    }
    __syncthreads();
}

constexpr int NPHASE = 21;
__global__ void __launch_bounds__(512, 2) mega(Params p_arg, int ph_lo, int ph_hi) {
    extern __shared__ __attribute__((aligned(16))) unsigned char lds_raw[];
    LAS unsigned char* lds = (LAS unsigned char*)lds_raw;
    cg::grid_group grid = cg::this_grid();
    if (threadIdx.x < 4) ((LAS unsigned*)(lds + 131072))[threadIdx.x] = 0u;
    __syncthreads();
    const XcdBarrier xbar = xcd_barrier_post((unsigned*)(kparams()->ws + WS_BAR), (volatile LAS unsigned*)(lds + 131072));
    if (ph_lo < 0) grid.sync();
#define G o_grid()
#define bid o_bid()
#define p kparams()
#define ws (kparams()->ws)
#define p kparams()
#define ws (kparams()->ws)
#pragma unroll 1
    for (int ph = ph_lo; ph < ph_hi; ++ph) {
        if (ph == 0) p0_prologue(lds, p);
        else if (ph <= 8) {
            const int hf = (ph - 1) >> 2, sub = (ph - 1) & 3, rowbase = hf ? 16384 : 0, rows = hf ? 16896 : 16384;
            if (sub == 0) {
                pg8::Gemm g{(const bf16_t*)(ws + WS_XB) + (size_t)rowbase * D, (const bf16_t*)(ws + WS_W1), rows, 4096, 1024}; pg8::StaticOrder S; S.init(rows, 4096, o_grid(), o_bid());
                Epi1 E{ws, rowbase}; pg8::gemm_phase<Epi1>(lds, g, S, E);
            } else if (sub == 1) h1_phase(lds, p, hf);
            else if (sub == 2) h2_phase(p, hf);
            else h3_phase(lds, p, hf);
        } else if (ph == 9 || ph == 12 || ph == 16 || ph == 19) {
            const size_t aoff = ph == 9 ? WS_XB : (ph == 16 ? WS_O : WS_H), woff = ph == 9 ? WS_W2 : (ph == 12 ? WS_W4 : (ph == 16 ? WS_W6 : WS_W8));
            const int K = (ph == 12 || ph == 19) ? DFF : 1024;
            pg8::Gemm g{(const bf16_t*)(ws + aoff), (const bf16_t*)(ws + woff), MT, 1024, K}; pg8::StaticOrder S; S.init(MT, 1024, o_grid(), o_bid());
            Epi2 E{ws}; pg8::gemm_phase<Epi2>(lds, g, S, E);
        } else if (ph == 11 || ph == 18) {
            pg8::Gemm g{(const bf16_t*)(ws + WS_XB), (const bf16_t*)(ws + (ph == 18 ? WS_W7 : WS_W3)), MT, 2 * DFF, 1024}; pg8::StaticOrder S; S.init(MT, 2 * DFF, o_grid(), o_bid());
            Epi3 E{ws}; pg8::gemm_phase<Epi3>(lds, g, S, E);
        } else if (ph == 10) x_phase<0, false>(p, p->in[6]);
        else if (ph == 13 || ph == 17) x_phase<1, false>(p, ph == 13 ? p->in[8] : p->in[6] + D);
        else if (ph == 14) {
            pg8::Gemm g{(const bf16_t*)(ws + WS_XB), (const bf16_t*)(ws + WS_W5), MT, 1536, 1024}; pg8::StaticOrder S; S.init(MT, 1536, o_grid(), o_bid());
            Epi5 E{ws, p->out}; pg8::gemm_phase<Epi5>(lds, g, S, E);
        } else if (ph == 15) attn_phase(lds, p);
        else if (ph == 20) x_phase<1, true>(p, p->in[8] + D);
        if (ph + 1 < ph_hi) xcd_barrier(xbar);
    }
#undef p
#undef ws
}

extern "C" void kernel_launch(void* const* d_in, const int* in_sizes, int n_in, void* d_out, int out_size, void* d_ws, size_t ws_size, hipStream_t stream) {
    static int grid = 0;
    if (!grid) {
        if (n_in != 20 || ws_size < WS_END) { fprintf(stderr, "kernel_launch: unexpected n_in %d / ws_size %zu (need %zu)\n", n_in, ws_size, (size_t)WS_END); return; }
        int dev = 0, cus = 0, per_cu = 0;
        hipGetDevice(&dev); hipDeviceGetAttribute(&cus, hipDeviceAttributeMultiprocessorCount, dev);
        hipFuncSetAttribute((const void*)mega, hipFuncAttributeMaxDynamicSharedMemorySize, LDS_BYTES);
        hipOccupancyMaxActiveBlocksPerMultiprocessor(&per_cu, (const void*)mega, 512, LDS_BYTES);
        if (per_cu < 1) { fprintf(stderr, "kernel_launch: occupancy query says %d blocks per CU\n", per_cu); per_cu = 1; }
        grid = cus * 1;
    }
    Params p{};
    for (int i = 0; i < 20; ++i) p.in[i] = (const float*)d_in[i];
    p.out = (float*)d_out; p.ws = (unsigned char*)d_ws;
    if (hipMemsetAsync((unsigned char*)d_ws + WS_BAR, 0, BAR_BYTES, stream) != hipSuccess) { fprintf(stderr, "kernel_launch: memset of the barrier words failed\n"); return; }
#if MK_ONE_LAUNCH
    int lo = 0, hi = NPHASE;
    void* args[] = {&p, &lo, &hi};
    hipError_t e = hipLaunchCooperativeKernel((const void*)mega, dim3(grid), dim3(512), args, LDS_BYTES, stream);
    if (e != hipSuccess) fprintf(stderr, "cooperative launch failed: %s (grid %d)\n", hipGetErrorString(e), grid);
#else
    for (int ph = 0; ph < NPHASE; ++ph) { hipLaunchKernelGGL(mega, dim3(grid), dim3(512), LDS_BYTES, stream, p, ph, ph + 1);
        if ((PROBE_DUP >> ph) & 1) for (int r = 0; r < PROBE_REP; ++r) hipLaunchKernelGGL(mega, dim3(grid), dim3(512), LDS_BYTES, stream, p, ph, ph + 1); }
#endif
}
```

```cpp
#include <hip/hip_runtime.h>
#include <hip/hip_cooperative_groups.h>
#include <cstdio>
#include <cstdint>
namespace cg = cooperative_groups;

#ifndef PROBE_DUP
#define PROBE_DUP 0
#define PROBE_REP 1
#endif
#ifndef MK_ONE_LAUNCH
#define MK_ONE_LAUNCH 1
#endif

#define LAS __attribute__((address_space(3)))
typedef unsigned short bf16_t;
typedef short bf16x8 __attribute__((ext_vector_type(8)));
typedef float f32x4 __attribute__((ext_vector_type(4)));
typedef float f32x2 __attribute__((ext_vector_type(2)));
typedef float f32x16 __attribute__((ext_vector_type(16)));
typedef unsigned u32x4 __attribute__((ext_vector_type(4)));
typedef unsigned u32x2 __attribute__((ext_vector_type(2)));

constexpr int D = 1024, TP = 8192, MP = 32768, MS = 512, MT = MP + MS, DFF = 2816;
constexpr float EPS = 1e-6f;
constexpr int XCD_BAR_WORDS_C = 3456;
constexpr size_t MiB = 1u << 20;
constexpr size_t WS_W1 = 0, WS_W2 = 8 * MiB, WS_W3 = 10 * MiB, WS_W4 = 21 * MiB, WS_W5 = 27 * MiB, WS_W6 = 30 * MiB, WS_W7 = 32 * MiB, WS_W8 = 43 * MiB;
constexpr size_t WS_ROPE = 49 * MiB, WS_RS = 51 * MiB, WS_LB = 51 * MiB + 512 * 1024, WS_SSQ = 52 * MiB;
constexpr size_t WS_BAR = 55 * MiB, BAR_BYTES = XCD_BAR_WORDS_C * 4;
constexpr size_t WS_XB = 56 * MiB, WS_O = 121 * MiB, WS_ST = 121 * MiB;
constexpr size_t WS_PART = 190 * MiB;
constexpr size_t WS_BIG = 251 * MiB;
constexpr size_t WS_QH = WS_BIG, WS_KK = WS_BIG + 33 * MiB, WS_VV = WS_BIG + 66 * MiB, WS_GG = WS_BIG + 99 * MiB, WS_BB = WS_BIG + 132 * MiB;
constexpr size_t WS_MIX = WS_BIG, WS_H = WS_BIG + 65 * MiB;
constexpr size_t WS_KB = WS_BIG + 65 * MiB, WS_VB = WS_BIG + 82 * MiB, WS_QB = WS_BIG + 99 * MiB;
constexpr size_t WS_END = WS_BIG + 244 * MiB;
constexpr size_t OUT_Y = 0, OUT_STP = 34078720, OUT_STS = 34603008, OUT_CKP = 36700160, OUT_CVP = 36831232, OUT_CKS = 36962304, OUT_CVS = 37486592;

constexpr int LDS_BYTES = 131072 + 16;

struct Params { const float* in[20]; float* out; unsigned char* ws; };
typedef const Params __attribute__((address_space(4)))* KP;
__device__ __forceinline__ KP kparams() { KP k = (KP)__builtin_amdgcn_kernarg_segment_ptr(); asm volatile("" : "+s"(k)); return k; }

__device__ __forceinline__ unsigned pk2(float lo, float hi) { unsigned r; asm("v_cvt_pk_bf16_f32 %0, %1, %2" : "=v"(r) : "v"(lo), "v"(hi)); return r; }
__device__ __forceinline__ float bflo(unsigned u) { return __uint_as_float(u << 16); }
__device__ __forceinline__ float bfhi(unsigned u) { return __uint_as_float(u & 0xffff0000u); }
__device__ __forceinline__ float frcp(float x) { return __builtin_amdgcn_rcpf(x); }
__device__ __forceinline__ float siluf(float v) { float c = fminf(fmaxf(v, -30.f), 30.f); return v * frcp(1.f + __expf(-c)); }
__device__ __forceinline__ float wave_sum(float v) {
#pragma unroll
    for (int o = 1; o < 64; o <<= 1) v += __shfl_xor(v, o);
    return v;
}
#define LDS_WAIT() asm volatile("s_waitcnt lgkmcnt(0)" ::: "memory")
__device__ __forceinline__ int o_tid() { int t = threadIdx.x; asm volatile("" : "+v"(t)); return t; }
__device__ __forceinline__ int o_bid() { int t = blockIdx.x; asm volatile("" : "+s"(t)); return t; }
__device__ __forceinline__ int o_grid() { int t = gridDim.x; asm volatile("" : "+s"(t)); return t; }

namespace pg8 {
constexpr int MP_ROWS = 32768;
constexpr int BM = 256, BK = 64, HALF = 128, HTB = HALF * BK * 2, STAGE_BYTES = 8 * HTB, NXCD = 8, WGM = 8;
__host__ __device__ __forceinline__ int lds_byte(int r, int c) { const int st = (r >> 4) * 2 + (c >> 5), rr = r & 15, cc = c & 31, ob = rr * 64 + cc * 2; return st * 1024 + (ob ^ (((ob >> 9) & 1) << 5)); }
__host__ __device__ __forceinline__ void stage_rc(int b, int& R, int& C) { const int st = b / 1024, sb = b % 1024, swz = sb ^ (((sb >> 9) & 1) << 5); R = (st >> 1) * 16 + swz / 64; C = (st & 1) * 32 + (swz % 64) / 2; }
__host__ __device__ __forceinline__ int perm32(int rho) { const int n = rho >> 4, i = rho & 15; return 8 * (i >> 2) + 4 * n + (i & 3); }
struct Unit { int pm, pn, koff, nt, part; };
struct Gemm { const bf16_t* A; const bf16_t* Bt; int M, N, K; };
struct SplitOrder {
    int nM, nN, nwg, G, c, ntk, nsplit;
    __device__ void init(int M, int N, int G_, int c_, int ntk_, int nsplit_) { nM = M / BM; nN = N / BM; nwg = nM * nN; G = G_; c = c_; ntk = ntk_; nsplit = nsplit_; }
    __device__ bool next(int i, Unit& u) const {
        const long L = (long)i * G + c; const bool whole = L < nwg;
        int wgid = whole ? (int)L : 0; { const int q = nwg / NXCD, r = nwg % NXCD, xcd = wgid % NXCD, off = wgid / NXCD; wgid = (xcd < r ? xcd * (q + 1) : r * (q + 1) + (xcd - r) * q) + off; }
        const int nig = WGM * nN, gid = wgid / nig, fm = gid * WGM, gsz = (nM - fm) < WGM ? (nM - fm) : WGM;
        const int pmA = fm + ((wgid % nig) % gsz), pnA = (wgid % nig) / gsz;
        const int l2 = (int)(L - nwg), partB = l2 >> 3;
        u.pm = whole ? pmA : nM + ((l2 >> 2) & 1); u.pn = whole ? pnA : (l2 & 3); u.koff = whole ? 0 : 4 * partB; u.nt = whole ? ntk : 4; u.part = whole ? -1 : partB;
        return whole || l2 < 8 * nsplit;
    }
};
template <class Epi>
__device__ __forceinline__ void gemm_phase(LAS unsigned char* lds, const Gemm g, const SplitOrder S, const Epi E) {
    const int tid = o_tid(), wid = __builtin_amdgcn_readfirstlane(tid >> 6), lane = tid & 63, wr = wid >> 2, wc = wid & 3, fr = lane & 15, fq = lane >> 4;
    const int K = g.K;
    unsigned voffA[2], voffB[2];
#pragma unroll
    for (int i = 0; i < 2; ++i) { int R, C; stage_rc(tid * 16 + i * 8192, R, C); const int Rb = (R & ~31) + perm32(R & 31);
        voffA[i] = (unsigned)(R * K + C) * 2u; voffB[i] = (unsigned)(Rb * K + C) * 2u; }
    const size_t kstep = (size_t)(BK * 2);
    const size_t hstep = (size_t)HALF * K * 2;
    const size_t tstep = 2 * hstep;
    const unsigned ldsw = (unsigned)wid * 1024u;
    const int aoff = lds_byte(wr * 64 + fr, fq * 8), boff = lds_byte(wc * 32 + fr, fq * 8);
#define PG8_SA(b, h) (((b) * 2 + (h)) * HTB)
#define PG8_SB(b, h) ((4 + (b) * 2 + (h)) * HTB)
#define PG8_STAGE(bufoff, gbase, voff) do { _Pragma("unroll") for (int _i = 0; _i < 2; ++_i) \
        __builtin_amdgcn_global_load_lds((const unsigned*)((const char*)(gbase) + (voff)[_i]), (LAS unsigned*)(lds + (bufoff) + ldsw + _i * 8192), 16, 0, 0); } while (0)
#define PG8_LDA(dst, b, h) do { _Pragma("unroll") for (int m = 0; m < 4; ++m) _Pragma("unroll") for (int k = 0; k < 2; ++k) dst[m][k] = *(const LAS bf16x8*)(lds + PG8_SA(b, h) + aoff + m * 2048 + k * 1024); } while (0)
#define PG8_LDB(dst, b, h) do { _Pragma("unroll") for (int n = 0; n < 2; ++n) _Pragma("unroll") for (int k = 0; k < 2; ++k) dst[n][k] = *(const LAS bf16x8*)(lds + PG8_SB(b, h) + boff + n * 2048 + k * 1024); } while (0)
#define PG8_MMA(ai, bj, At, Bt) do { __builtin_amdgcn_s_setprio(1); _Pragma("unroll") for (int m = 0; m < 4; ++m) _Pragma("unroll") for (int n = 0; n < 2; ++n) _Pragma("unroll") for (int k = 0; k < 2; ++k) \
        acc[ai][bj][m][n] = __builtin_amdgcn_mfma_f32_16x16x32_bf16(Bt[n][k], At[m][k], acc[ai][bj][m][n], 0, 0, 0); __builtin_amdgcn_s_setprio(0); } while (0)
#define PG8_WAIT_V(n) asm volatile("s_waitcnt vmcnt(" #n ")" ::: "memory")
#define PG8_WAIT_L(n) asm volatile("s_waitcnt lgkmcnt(" #n ")" ::: "memory")
#define PG8_BAR __builtin_amdgcn_s_barrier()
#define PG8_SCHED __builtin_amdgcn_sched_barrier(0)
    Unit cur, nxt; int ui = 0;
    if (!S.next(0, cur)) return;
    f32x4 acc[2][2][4][2];
#pragma unroll
    for (int a = 0; a < 2; ++a)
#pragma unroll
        for (int b = 0; b < 2; ++b)
#pragma unroll
            for (int m = 0; m < 4; ++m)
#pragma unroll
                for (int n = 0; n < 2; ++n) acc[a][b][m][n] = (f32x4){0.f, 0.f, 0.f, 0.f};
    bf16x8 At[4][2], B0[2][2], B1[2][2];
    const char* cA = (const char*)g.A + (size_t)cur.pm * tstep + (size_t)cur.koff * kstep; const char* cB = (const char*)g.Bt + (size_t)cur.pn * tstep + (size_t)cur.koff * kstep;
    PG8_STAGE(PG8_SB(0, 0), cB, voffB); PG8_STAGE(PG8_SB(0, 1), cB + hstep, voffB); PG8_STAGE(PG8_SA(0, 0), cA, voffA); PG8_STAGE(PG8_SA(0, 1), cA + hstep, voffA);
    if (wr == 1) PG8_BAR;
    PG8_WAIT_V(2); PG8_BAR;
    PG8_STAGE(PG8_SB(1, 0), cB + kstep, voffB); PG8_STAGE(PG8_SA(1, 0), cA + kstep, voffA); PG8_STAGE(PG8_SB(1, 1), cB + hstep + kstep, voffB);
    PG8_WAIT_V(6); PG8_BAR;
    for (;;) {
        const bool has_next = S.next(ui + 1, nxt);
        const char* nA = has_next ? (const char*)g.A + (size_t)nxt.pm * tstep + (size_t)nxt.koff * kstep : cA; const char* nB = has_next ? (const char*)g.Bt + (size_t)nxt.pn * tstep + (size_t)nxt.koff * kstep : cB;
        const int nt = cur.nt;
        for (int t = 0; t < nt; t += 2) {
            const bool last = (t == nt - 2);
            const char* a1 = cA + (size_t)(t + 1) * kstep;
            const char* a2 = last ? nA : cA + (size_t)(t + 2) * kstep; const char* b2 = last ? nB : cB + (size_t)(t + 2) * kstep;
            const char* a3 = a2 + kstep; const char* b3 = b2 + kstep;
            PG8_LDB(B0, 0, 0); PG8_LDB(B1, 0, 1); PG8_SCHED; PG8_LDA(At, 0, 0); PG8_STAGE(PG8_SA(1, 1), a1 + hstep, voffA);
            PG8_WAIT_V(8); PG8_WAIT_L(0); PG8_BAR; PG8_MMA(0, 0, At, B0); PG8_MMA(0, 1, At, B1); PG8_BAR; PG8_SCHED;
            PG8_LDA(At, 0, 1); PG8_STAGE(PG8_SB(0, 0), b2, voffB); PG8_STAGE(PG8_SB(0, 1), b2 + hstep, voffB); PG8_STAGE(PG8_SA(0, 0), a2, voffA);
            PG8_WAIT_V(8); PG8_WAIT_L(0); PG8_BAR; PG8_MMA(1, 0, At, B0); PG8_MMA(1, 1, At, B1); PG8_BAR; PG8_SCHED;
            PG8_LDB(B0, 1, 0); PG8_LDB(B1, 1, 1); PG8_SCHED; PG8_LDA(At, 1, 0); PG8_STAGE(PG8_SA(0, 1), a2 + hstep, voffA);
            PG8_WAIT_V(8); PG8_WAIT_L(0); PG8_BAR; PG8_MMA(0, 0, At, B0); PG8_MMA(0, 1, At, B1); PG8_BAR; PG8_SCHED;
            PG8_LDA(At, 1, 1); PG8_STAGE(PG8_SB(1, 0), b3, voffB); PG8_STAGE(PG8_SB(1, 1), b3 + hstep, voffB); PG8_STAGE(PG8_SA(1, 0), a3, voffA);
            PG8_WAIT_V(8); PG8_WAIT_L(0); PG8_BAR; PG8_MMA(1, 0, At, B0); PG8_MMA(1, 1, At, B1); PG8_BAR; PG8_SCHED;
        }
        if (wr == 0) PG8_BAR;
        E(acc, cur, wr, wc, fr, fq);
        if (!has_next) break;
#pragma unroll
        for (int a = 0; a < 2; ++a)
#pragma unroll
            for (int b = 0; b < 2; ++b)
#pragma unroll
                for (int m = 0; m < 4; ++m)
#pragma unroll
                    for (int n = 0; n < 2; ++n) acc[a][b][m][n] = (f32x4){0.f, 0.f, 0.f, 0.f};
        cur = nxt; cA = nA; cB = nB; ++ui;
        if (wr == 1) PG8_BAR;
    }
    PG8_WAIT_V(0);
    PG8_BAR;
#undef PG8_SA
#undef PG8_SB
#undef PG8_STAGE
#undef PG8_LDA
#undef PG8_LDB
#undef PG8_MMA
#undef PG8_WAIT_V
#undef PG8_WAIT_L
#undef PG8_BAR
#undef PG8_SCHED
}
}
using pg8::Unit;

__device__ __forceinline__ u32x4 pack8(const f32x4 a, const f32x4 b) { u32x4 o; o.x = pk2(a[0], a[1]); o.y = pk2(a[2], a[3]); o.z = pk2(b[0], b[1]); o.w = pk2(b[2], b[3]); return o; }

struct Epi1 {
    unsigned char* ws; int rowbase;
    __device__ __forceinline__ void operator()(f32x4 (&acc)[2][2][4][2], const Unit& u, int wr, int wc, int fr, int fq) const {
        bf16_t* KK = (bf16_t*)(ws + WS_KK); float* BB = (float*)(ws + WS_BB); const float* RS = (const float*)(ws + WS_RS); const float* LB = (const float*)(ws + WS_LB);
        const int type = u.pn >> 2, cs = (u.pn & 3) * 256 + wc * 32 + fq * 8;
        int lrow0 = u.pm * 256 + wr * 64 + fr; asm volatile("" : "+v"(lrow0));
#pragma unroll
        for (int ai = 0; ai < 2; ++ai)
#pragma unroll
            for (int m = 0; m < 4; ++m) { const float rs = RS[rowbase + lrow0 + ai * 128 + m * 16];
#pragma unroll
                for (int bj = 0; bj < 2; ++bj)
#pragma unroll
                    for (int n = 0; n < 2; ++n) acc[ai][bj][m][n] *= rs; }
        if (type != 1) {
            bf16_t* O = (bf16_t*)(ws + WS_QH + (size_t)(type == 0 ? 0 : (type == 2 ? 66 : 99)) * MiB);
#pragma unroll
            for (int ai = 0; ai < 2; ++ai)
#pragma unroll
                for (int m = 0; m < 4; ++m) { bf16_t* rowp = O + (size_t)(lrow0 + ai * 128 + m * 16) * D + cs;
#pragma unroll
                    for (int bj = 0; bj < 2; ++bj) { f32x4 v0 = acc[ai][bj][m][0], v1 = acc[ai][bj][m][1];
                        if (type != 2) {
#pragma unroll
                            for (int j = 0; j < 4; ++j) { v0[j] = siluf(v0[j]); v1[j] = siluf(v1[j]); } }
                        *(u32x4*)(rowp + bj * 128) = pack8(v0, v1); } }
        } else {
            const bool smp = (rowbase + u.pm * 256) >= MP;
#pragma unroll
            for (int bj = 0; bj < 2; ++bj) {
                const f32x4 lb0 = *(const f32x4*)(LB + cs + bj * 128), lb1 = *(const f32x4*)(LB + cs + bj * 128 + 4);
#pragma unroll
                for (int ai = 0; ai < 2; ++ai)
#pragma unroll
                    for (int m = 0; m < 4; ++m) {
                        f32x4 k0, k1;
#pragma unroll
                        for (int j = 0; j < 4; ++j) {
                            { const float v = fminf(fmaxf(acc[ai][bj][m][0][j], -30.f), 30.f); const float kk = (1.f - lb0[j]) * frcp(1.f + __expf(v)); k0[j] = kk; acc[ai][bj][m][0][j] = __logf(1.f - kk); }
                            { const float v = fminf(fmaxf(acc[ai][bj][m][1][j], -30.f), 30.f); const float kk = (1.f - lb1[j]) * frcp(1.f + __expf(v)); k1[j] = kk; acc[ai][bj][m][1][j] = __logf(1.f - kk); }
                        }
                        *(u32x4*)(KK + (size_t)(lrow0 + ai * 128 + m * 16) * D + cs + bj * 128) = pack8(k0, k1);
                    }
            }
#pragma unroll
            for (int ai = 0; ai < 2; ++ai)
#pragma unroll
                for (int bj = 0; bj < 2; ++bj)
#pragma unroll
                    for (int n = 0; n < 2; ++n)
#pragma unroll
                        for (int j = 0; j < 4; ++j) {
                            float v[4], tot[4];
#pragma unroll
                            for (int m = 0; m < 4; ++m) { float x = acc[ai][bj][m][n][j];
#pragma unroll
                                for (int d = 1; d < 16; d <<= 1) { const float t = __shfl_up(x, d, 16); if (fr >= d) x += t; }
                                v[m] = x; tot[m] = __shfl(x, 15, 16); }
                            if (!smp) { v[1] += tot[0]; v[2] += tot[0] + tot[1]; v[3] += (tot[0] + tot[1]) + tot[2]; }
                            else { v[1] += tot[0]; v[3] += tot[2]; }
#pragma unroll
                            for (int m = 0; m < 4; ++m) acc[ai][bj][m][n][j] = v[m];
                        }
#pragma unroll
            for (int ai = 0; ai < 2; ++ai)
#pragma unroll
                for (int m = 0; m < 4; ++m) { float* rowp = BB + (size_t)(lrow0 + ai * 128 + m * 16) * D + cs;
#pragma unroll
                    for (int bj = 0; bj < 2; ++bj) { *(f32x4*)(rowp + bj * 128) = acc[ai][bj][m][0]; *(f32x4*)(rowp + bj * 128 + 4) = acc[ai][bj][m][1]; } }
        }
    }
};
struct Epi2 {
    unsigned char* ws;
    __device__ __forceinline__ void operator()(f32x4 (&acc)[2][2][4][2], const Unit& u, int wr, int wc, int fr, int fq) const {
        bf16_t* MIX = (bf16_t*)(ws + WS_MIX); float* SSQ = (float*)(ws + WS_SSQ); asm volatile("" : "+v"(fr));
        if (u.part >= 0) {
            float* PART = (float*)(ws + WS_PART) + (size_t)u.part * (MS * D);
#pragma unroll
            for (int ai = 0; ai < 2; ++ai)
#pragma unroll
                for (int m = 0; m < 4; ++m) { const int lr = (u.pm - MP / 256) * 256 + ai * 128 + wr * 64 + m * 16 + fr; float* rowp = PART + (size_t)lr * D + u.pn * 256 + wc * 32 + fq * 8;
#pragma unroll
                    for (int bj = 0; bj < 2; ++bj) { *(f32x4*)(rowp + bj * 128) = acc[ai][bj][m][0]; *(f32x4*)(rowp + bj * 128 + 4) = acc[ai][bj][m][1]; } }
            return;
        }
#pragma unroll
        for (int ai = 0; ai < 2; ++ai)
#pragma unroll
            for (int m = 0; m < 4; ++m) { const int row = u.pm * 256 + ai * 128 + wr * 64 + m * 16 + fr; float ss = 0.f;
                bf16_t* rowp = MIX + (size_t)row * D + u.pn * 256 + wc * 32 + fq * 8;
#pragma unroll
                for (int bj = 0; bj < 2; ++bj) { const f32x4 v0 = acc[ai][bj][m][0], v1 = acc[ai][bj][m][1];
#pragma unroll
                    for (int j = 0; j < 4; ++j) ss += v0[j] * v0[j] + v1[j] * v1[j];
                    *(u32x4*)(rowp + bj * 128) = pack8(v0, v1); }
                ss += __shfl_xor(ss, 16); ss += __shfl_xor(ss, 32);
                if (fq == 0) SSQ[(size_t)row * 16 + u.pn * 4 + wc] = ss; }
    }
};
struct Epi3 {
    unsigned char* ws;
    __device__ __forceinline__ void operator()(f32x4 (&acc)[2][2][4][2], const Unit& u, int wr, int wc, int fr, int fq) const {
        bf16_t* H = (bf16_t*)(ws + WS_H); const float* RS = (const float*)(ws + WS_RS); asm volatile("" : "+v"(fr));
#pragma unroll
        for (int ai = 0; ai < 2; ++ai)
#pragma unroll
            for (int m = 0; m < 4; ++m) { const int row = u.pm * 256 + ai * 128 + wr * 64 + m * 16 + fr; const float rs = RS[row];
                f32x4 h0, h1;
#pragma unroll
                for (int j = 0; j < 4; ++j) { h0[j] = siluf(acc[ai][0][m][0][j] * rs) * (acc[ai][1][m][0][j] * rs); h1[j] = siluf(acc[ai][0][m][1][j] * rs) * (acc[ai][1][m][1][j] * rs); }
                *(u32x4*)(H + (size_t)row * DFF + u.pn * 128 + wc * 32 + fq * 8) = pack8(h0, h1); }
    }
};
struct Epi5 {
    unsigned char* ws; float* out;
    __device__ __forceinline__ void operator()(f32x4 (&acc)[2][2][4][2], const Unit& u, int wr, int wc, int fr, int fq) const {
        bf16_t* Qb = (bf16_t*)(ws + WS_QB); const float* RS = (const float*)(ws + WS_RS); const float* ROPE = (const float*)(ws + WS_ROPE); asm volatile("" : "+v"(fr));
        const int d1 = fq * 8;
#pragma unroll
        for (int ai = 0; ai < 2; ++ai)
#pragma unroll
            for (int m = 0; m < 4; ++m) { const int row = u.pm * 256 + ai * 128 + wr * 64 + m * 16 + fr; const float rs = RS[row];
                int pos, crow, cb; bool smp = row >= MP;
                if (!smp) { const int t = row & (TP - 1); pos = t; cb = row >> 13; crow = t - (TP - 128); }
                else { const int lr = row - MP; const int t = lr & 31; pos = 2048 + t; cb = lr >> 5; crow = 96 + t; }
                f32x4 x1a = acc[ai][0][m][0] * rs, x1b = acc[ai][0][m][1] * rs, x2a = acc[ai][1][m][0] * rs, x2b = acc[ai][1][m][1] * rs;
                if (u.pn != 1) {
                    const f32x4* rp = (const f32x4*)(ROPE + ((size_t)pos * 32 + d1) * 2);
                    const f32x4 r0 = rp[0], r1 = rp[1], r2 = rp[2], r3 = rp[3];
                    f32x4 ca = {r0[0], r0[2], r1[0], r1[2]}, sa = {r0[1], r0[3], r1[1], r1[3]}, cb4 = {r2[0], r2[2], r3[0], r3[2]}, sb4 = {r2[1], r2[3], r3[1], r3[3]};
                    const f32x4 o1a = x1a * ca - x2a * sa, o2a = x2a * ca + x1a * sa, o1b = x1b * cb4 - x2b * sb4, o2b = x2b * cb4 + x1b * sb4;
                    x1a = o1a; x2a = o2a; x1b = o1b; x2b = o2b;
                }
                if (u.pn >= 2) {
                    const int hq = (u.pn - 2) * 4 + wc; bf16_t* q = Qb + (size_t)row * D + hq * 64 + d1;
                    *(u32x4*)q = pack8(x1a * 0.125f, x1b * 0.125f); *(u32x4*)(q + 32) = pack8(x2a * 0.125f, x2b * 0.125f);
                } else {
                    bf16_t* kb = (bf16_t*)(ws + WS_KB + (size_t)(u.pn == 0 ? 0 : 17) * MiB) + (size_t)row * 256 + wc * 64 + d1;
                    *(u32x4*)kb = pack8(x1a, x1b); *(u32x4*)(kb + 32) = pack8(x2a, x2b);
                    if (crow >= 0) {
                        float* co = out + (smp ? (u.pn == 0 ? OUT_CKS : OUT_CVS) : (u.pn == 0 ? OUT_CKP : OUT_CVP)) + ((size_t)(cb * 128 + crow) * 4 + wc) * 64 + d1;
                        *(f32x4*)co = x1a; *(f32x4*)(co + 4) = x1b; *(f32x4*)(co + 32) = x2a; *(f32x4*)(co + 36) = x2b;
                    }
                }
            }
    }
};

__device__ __forceinline__ void tr_item(const float* W, int ldw, int col0, const float* fold, bf16_t* WT, int K, int drow0, int k0, LAS float* scr, int lane) {
    float wreg[32];
#pragma unroll
    for (int i = 0; i < 32; ++i) { const int kk = 2 * i + (lane >> 5); wreg[i] = W[(size_t)(k0 + kk) * ldw + col0 + (lane & 31)]; }
    if (fold) {
#pragma unroll
        for (int i = 0; i < 32; ++i) wreg[i] *= fold[k0 + 2 * i + (lane >> 5)]; }
#pragma unroll
    for (int i = 0; i < 32; ++i) scr[(2 * i + (lane >> 5)) * 33 + (lane & 31)] = wreg[i];
    LDS_WAIT();
    const int c = lane & 7;
#pragma unroll
    for (int j = 0; j < 4; ++j) { const int n = (lane >> 3) + 8 * j; const LAS float* s = scr + (8 * c) * 33 + n;
        u32x4 o; o.x = pk2(s[0 * 33], s[1 * 33]); o.y = pk2(s[2 * 33], s[3 * 33]); o.z = pk2(s[4 * 33], s[5 * 33]); o.w = pk2(s[6 * 33], s[7 * 33]);
        *(u32x4*)(WT + (size_t)(drow0 + n) * K + k0 + 8 * c) = o; }
    LDS_WAIT();
}
__device__ __forceinline__ const float* xrow_ptr(KP p, int row) { return row < MP ? p->in[0] + (size_t)row * D : p->in[1] + (size_t)(row - MP) * D; }

__device__ __forceinline__ void p0_prologue(LAS unsigned char* lds, KP p) {
    const int tid = o_tid(), lane = tid & 63, wave = tid >> 6;
    LAS float* scr = (LAS float*)(lds + wave * 16384);
    const int bidx = o_bid(), gdim = o_grid();
    const int gw = bidx * 8 + wave, NGW = gdim * 8;
    unsigned char* ws = p->ws;
    constexpr int I1 = 16 * 128, I2 = 16 * 32, I3 = 16 * 176, I4 = 44 * 32, I5 = 16 * 48, I6 = 16 * 32, I7 = I3, I8 = I4;
    constexpr int NIT = I1 + I2 + I3 + I4 + I5 + I6 + I7 + I8;
    for (int it = gw; it < NIT; it += NGW) {
        int r = it;
        if (r < I1) { const int nb = r % 128, kb = r / 128; tr_item(p->in[11], 4096, 32 * nb, p->in[5], (bf16_t*)(ws + WS_W1), 1024, 32 * nb, 64 * kb, scr, lane); continue; } r -= I1;
        if (r < I2) { const int nb = r % 32, kb = r / 32; tr_item(p->in[14], 1024, 32 * nb, nullptr, (bf16_t*)(ws + WS_W2), 1024, 32 * nb, 64 * kb, scr, lane); continue; } r -= I2;
        if (r < I3) { const int nb = r % 176, kb = r / 176; const int rho = 32 * nb, col = ((rho >> 7) & 1) * DFF + 128 * (rho >> 8) + (rho & 127);
            tr_item(p->in[9], 2 * DFF, col, p->in[7], (bf16_t*)(ws + WS_W3), 1024, rho, 64 * kb, scr, lane); continue; } r -= I3;
        if (r < I4) { const int nb = r % 32, kb = r / 32; tr_item(p->in[10], 1024, 32 * nb, nullptr, (bf16_t*)(ws + WS_W4), DFF, 32 * nb, 64 * kb, scr, lane); continue; } r -= I4;
        if (r < I5) { const int nb = r % 48, kb = r / 48; const int rho = 32 * nb, cc = 256 * (rho >> 8) + 64 * ((rho & 127) >> 5) + 32 * ((rho >> 7) & 1);
            if (cc < 512) tr_item(p->in[16], 512, cc, p->in[15], (bf16_t*)(ws + WS_W5), 1024, rho, 64 * kb, scr, lane);
            else tr_item(p->in[17], 1024, cc - 512, p->in[5] + D, (bf16_t*)(ws + WS_W5), 1024, rho, 64 * kb, scr, lane);
            continue; } r -= I5;
        if (r < I6) { const int nb = r % 32, kb = r / 32; tr_item(p->in[19], 1024, 32 * nb, nullptr, (bf16_t*)(ws + WS_W6), 1024, 32 * nb, 64 * kb, scr, lane); continue; } r -= I6;
        if (r < I7) { const int nb = r % 176, kb = r / 176; const int rho = 32 * nb, col = ((rho >> 7) & 1) * DFF + 128 * (rho >> 8) + (rho & 127);
            tr_item(p->in[9] + (size_t)D * 2 * DFF, 2 * DFF, col, p->in[7] + D, (bf16_t*)(ws + WS_W7), 1024, rho, 64 * kb, scr, lane); continue; } r -= I7;
        { const int nb = r % 32, kb = r / 32; tr_item(p->in[10] + (size_t)DFF * D, 1024, 32 * nb, nullptr, (bf16_t*)(ws + WS_W8), DFF, 32 * nb, 64 * kb, scr, lane); }
    }
    bf16_t* XB = (bf16_t*)(ws + WS_XB); float* RS = (float*)(ws + WS_RS);
    for (int row0 = gw; row0 < MT; row0 += 4 * NGW) {
        f32x4 v[4][4];
#pragma unroll
        for (int q = 0; q < 4; ++q) { const int row = row0 + q * NGW; const f32x4* xr = (const f32x4*)xrow_ptr(p, row < MT ? row : row0) + lane;
#pragma unroll
            for (int j = 0; j < 4; ++j) v[q][j] = xr[64 * j]; }
#pragma unroll
        for (int q = 0; q < 4; ++q) { const int row = row0 + q * NGW; float s = 0.f;
#pragma unroll
            for (int j = 0; j < 4; ++j) s += (v[q][j][0] * v[q][j][0] + v[q][j][1] * v[q][j][1]) + (v[q][j][2] * v[q][j][2] + v[q][j][3] * v[q][j][3]);
            s = wave_sum(s);
            if (row < MT) { u32x2* o = (u32x2*)(XB + (size_t)row * D) + lane;
#pragma unroll
                for (int j = 0; j < 4; ++j) { u32x2 w; w.x = pk2(v[q][j][0], v[q][j][1]); w.y = pk2(v[q][j][2], v[q][j][3]); o[64 * j] = w; }
                if (lane == 0) RS[row] = rsqrtf(s * (1.f / D) + EPS); }
        }
    }
    const int gt = bidx * 512 + tid, NGT = gdim * 512;
    float* ROPE = (float*)(ws + WS_ROPE);
    for (int i = gt; i < TP * 32; i += NGT) { const int pos = i >> 5, d = i & 31;
        const float inv = exp2f(-(float)d * (13.287712379549449f / 32.f));
        const float ang = (float)pos * inv;
        double rev = (double)ang * 0.15915494309189535; rev -= __builtin_rint(rev);
        const float rr = (float)rev;
        ROPE[2 * i] = __builtin_amdgcn_cosf(rr); ROPE[2 * i + 1] = __builtin_amdgcn_sinf(rr); }
    float* LB = (float*)(ws + WS_LB);
    for (int i = gt; i < D; i += NGT) { const float a0 = p->in[12][i], a1 = p->in[12][D + i]; LB[i] = 1.f / (1.f + expf(a1 - a0)); }
    for (int i = gt; i < 16 * 96 * 64; i += NGT) { const int b = i / (96 * 64), rem = i % (96 * 64);
        const f32x4 kv = *((const f32x4*)(p->in[3] + (size_t)b * 32768 + 32 * 256) + rem), vv = *((const f32x4*)(p->in[4] + (size_t)b * 32768 + 32 * 256) + rem);
        *((f32x4*)(p->out + OUT_CKS + (size_t)b * 32768) + rem) = kv; *((f32x4*)(p->out + OUT_CVS + (size_t)b * 32768) + rem) = vv; }
}

__device__ __forceinline__ f32x16 mfma32(bf16x8 a, bf16x8 b, f32x16 c) { return __builtin_amdgcn_mfma_f32_32x32x16_bf16(a, b, c, 0, 0, 0); }
__device__ __forceinline__ f32x16 zero16() { f32x16 z; for (int i = 0; i < 16; ++i) z[i] = 0.f; return z; }

struct HUnit { int row0, L, h, sb; };
__device__ __forceinline__ HUnit hunit(int u, int hf) { HUnit r;
    if (u < 2048) { r.row0 = (2 * hf + (u >> 10)) * TP + 64 * ((u >> 3) & 127); r.L = 64; r.h = u & 7; r.sb = -1; }
    else { const int uu = u - 2048; r.sb = uu >> 3; r.h = uu & 7; r.row0 = MP + 32 * r.sb; r.L = 32; }
    return r; }

__device__ __forceinline__ void h1_phase(LAS unsigned char* lds, KP p, int hf) {
    const int tid = o_tid(), lane = tid & 63, w = tid >> 6, r32 = lane & 31, hh = lane >> 5;
    LAS bf16_t* KT = (LAS bf16_t*)lds; LAS bf16_t* VT = KT + 128 * 72;
    const int nunits = hf ? 2176 : 2048, rowbase = hf ? 16384 : 0;
    const float* BB = (const float*)(p->ws + WS_BB); const bf16_t* KK = (const bf16_t*)(p->ws + WS_KK); const bf16_t* VV = (const bf16_t*)(p->ws + WS_VV);
    bf16_t* ST = (bf16_t*)(p->ws + WS_ST);
    const int r = tid >> 3, c16 = (tid & 7) * 16;
    const int bidx = o_bid(), gdim = o_grid();
    for (int u = bidx; u < nunits; u += gdim) {
        const HUnit hu = hunit(u, hf); const int lrow0 = hu.row0 - rowbase;
        const size_t off = (size_t)(lrow0 + r) * D + hu.h * 128 + c16, offl = (size_t)(lrow0 + hu.L - 1) * D + hu.h * 128 + c16;
        const bool valid = r < hu.L;
#pragma unroll
        for (int q = 0; q < 2; ++q) {
            u32x4 kq = {0u, 0u, 0u, 0u}, vq = {0u, 0u, 0u, 0u}; f32x4 b0 = {0, 0, 0, 0}, b1 = b0, l0 = b0, l1 = b0;
            if (valid) { kq = *(const u32x4*)(KK + off + 8 * q); vq = *(const u32x4*)(VV + off + 8 * q);
                b0 = *(const f32x4*)(BB + off + 8 * q); b1 = *(const f32x4*)(BB + off + 8 * q + 4); l0 = *(const f32x4*)(BB + offl + 8 * q); l1 = *(const f32x4*)(BB + offl + 8 * q + 4); }
            float kt[8];
            kt[0] = bflo(kq.x) * __expf(l0[0] - b0[0]); kt[1] = bfhi(kq.x) * __expf(l0[1] - b0[1]); kt[2] = bflo(kq.y) * __expf(l0[2] - b0[2]); kt[3] = bfhi(kq.y) * __expf(l0[3] - b0[3]);
            kt[4] = bflo(kq.z) * __expf(l1[0] - b1[0]); kt[5] = bfhi(kq.z) * __expf(l1[1] - b1[1]); kt[6] = bflo(kq.w) * __expf(l1[2] - b1[2]); kt[7] = bfhi(kq.w) * __expf(l1[3] - b1[3]);
            const unsigned vw[4] = {vq.x, vq.y, vq.z, vq.w};
#pragma unroll
            for (int i = 0; i < 4; ++i) { const unsigned pk = pk2(kt[2 * i], kt[2 * i + 1]); const int cc = c16 + 8 * q + 2 * i;
                KT[cc * 72 + r] = (bf16_t)(pk & 0xffffu); KT[(cc + 1) * 72 + r] = (bf16_t)(pk >> 16);
                VT[cc * 72 + r] = (bf16_t)(vw[i] & 0xffffu); VT[(cc + 1) * 72 + r] = (bf16_t)(vw[i] >> 16); }
        }
        __syncthreads();
        const int dvt = w >> 1, dk0 = (w & 1) * 2;
        f32x16 acc0 = zero16(), acc1 = zero16();
#pragma unroll
        for (int ks = 0; ks < 4; ++ks) {
            const bf16x8 a = *(const LAS bf16x8*)(VT + (dvt * 32 + r32) * 72 + ks * 16 + hh * 8);
            const bf16x8 bq0 = *(const LAS bf16x8*)(KT + (dk0 * 32 + r32) * 72 + ks * 16 + hh * 8);
            const bf16x8 bq1 = *(const LAS bf16x8*)(KT + ((dk0 + 1) * 32 + r32) * 72 + ks * 16 + hh * 8);
            acc0 = mfma32(a, bq0, acc0); acc1 = mfma32(a, bq1, acc1);
        }
        bf16_t* st = ST + (size_t)u * 16384;
        if (hu.L == 64) {
#pragma unroll
            for (int reg = 0; reg < 16; ++reg) { const int dv = dvt * 32 + (reg & 3) + 8 * (reg >> 2) + 4 * hh;
                st[dv * 128 + dk0 * 32 + r32] = (bf16_t)(pk2(acc0[reg], 0.f) & 0xffffu); st[dv * 128 + (dk0 + 1) * 32 + r32] = (bf16_t)(pk2(acc1[reg], 0.f) & 0xffffu); }
        } else {
            const float* s0p = p->in[2] + (size_t)(hu.sb * 8 + hu.h) * 16384; float* sop = p->out + OUT_STS + (size_t)(hu.sb * 8 + hu.h) * 16384;
            const float* bl = BB + (size_t)(lrow0 + 31) * D + hu.h * 128;
#pragma unroll
            for (int jt = 0; jt < 2; ++jt) { const int dk = (dk0 + jt) * 32 + r32; const float dec = __expf(bl[dk]);
#pragma unroll
                for (int reg = 0; reg < 16; ++reg) { const int dv = dvt * 32 + (reg & 3) + 8 * (reg >> 2) + 4 * hh;
                    const float s0 = s0p[dk * 128 + dv]; const float a = jt ? acc1[reg] : acc0[reg];
                    sop[dk * 128 + dv] = dec * s0 + a; st[dv * 128 + dk] = (bf16_t)(pk2(s0, 0.f) & 0xffffu); } }
        }
        __syncthreads();
    }
}
__device__ __forceinline__ void h2_phase(KP p, int hf) {
    const int tid = o_tid(); const int bidx = o_bid(), gdim = o_grid();
    const float* BB = (const float*)(p->ws + WS_BB); unsigned* ST = (unsigned*)(p->ws + WS_ST);
    for (int it = bidx * 512 + tid; it < 16 * 8192; it += gdim * 512) {
        const int pair = it >> 13, e = it & 8191, dv = e >> 6, dk = (e & 63) * 2, bl = pair >> 3, h = pair & 7;
        float s0 = 0.f, s1 = 0.f;
        unsigned* sp = ST + ((size_t)(bl * 1024 + h) * 16384 + dv * 128 + dk) / 2;
        const float* bp = BB + (size_t)(bl * TP + 63) * D + h * 128 + dk;
        for (int c0 = 0; c0 < 128; c0 += 8) {
            unsigned uu[8]; f32x2 dd[8];
#pragma unroll
            for (int i = 0; i < 8; ++i) { uu[i] = sp[(size_t)(c0 + i) * 65536]; dd[i] = *(const f32x2*)(bp + (size_t)(c0 + i) * 64 * D); }
#pragma unroll
            for (int i = 0; i < 8; ++i) { sp[(size_t)(c0 + i) * 65536] = pk2(s0, s1); s0 = __expf(dd[i][0]) * s0 + bflo(uu[i]); s1 = __expf(dd[i][1]) * s1 + bfhi(uu[i]); }
        }
        float* so = p->out + OUT_STP + (size_t)((2 * hf + bl) * 8 + h) * 16384;
        so[dk * 128 + dv] = s0; so[(dk + 1) * 128 + dv] = s1;
    }
}
__device__ __forceinline__ void h3_phase(LAS unsigned char* lds, KP p, int hf) {
    const int tid = o_tid(), lane = tid & 63, w = tid >> 6, r32 = lane & 31, hh = lane >> 5;
    LAS bf16_t* Qs = (LAS bf16_t*)lds; LAS bf16_t* Ks = Qs + 64 * 136; LAS bf16_t* VT = Ks + 64 * 136; LAS bf16_t* Ss = VT + 128 * 72; LAS float* red = (LAS float*)(Ss + 128 * 136);
    const int nunits = hf ? 2176 : 2048, rowbase = hf ? 16384 : 0;
    const float* BB = (const float*)(p->ws + WS_BB); const bf16_t* KK = (const bf16_t*)(p->ws + WS_KK); const bf16_t* VV = (const bf16_t*)(p->ws + WS_VV);
    const bf16_t* QH = (const bf16_t*)(p->ws + WS_QH); const bf16_t* GG = (const bf16_t*)(p->ws + WS_GG);
    const bf16_t* ST = (const bf16_t*)(p->ws + WS_ST); bf16_t* O2 = (bf16_t*)(p->ws + WS_XB);
    const float* gnorm = p->in[13];
    const int r = tid >> 3, c16 = (tid & 7) * 16;
    const int bidx = o_bid(), gdim = o_grid();
    for (int u = bidx; u < nunits; u += gdim) {
        const HUnit hu = hunit(u, hf); const int lrow0 = hu.row0 - rowbase;
        const size_t off = (size_t)(lrow0 + r) * D + hu.h * 128 + c16;
        const bool valid = r < hu.L;
#pragma unroll
        for (int q = 0; q < 2; ++q) {
            u32x4 kq = {0u, 0u, 0u, 0u}, vq = kq, qq = kq; f32x4 b0 = {0, 0, 0, 0}, b1 = b0;
            if (valid) { kq = *(const u32x4*)(KK + off + 8 * q); vq = *(const u32x4*)(VV + off + 8 * q); qq = *(const u32x4*)(QH + off + 8 * q);
                b0 = *(const f32x4*)(BB + off + 8 * q); b1 = *(const f32x4*)(BB + off + 8 * q + 4); }
            float eb[8], kf[8], qf[8];
#pragma unroll
            for (int j = 0; j < 4; ++j) { eb[j] = __expf(b0[j]); eb[4 + j] = __expf(b1[j]); }
            kf[0] = bflo(kq.x); kf[1] = bfhi(kq.x); kf[2] = bflo(kq.y); kf[3] = bfhi(kq.y); kf[4] = bflo(kq.z); kf[5] = bfhi(kq.z); kf[6] = bflo(kq.w); kf[7] = bfhi(kq.w);
            qf[0] = bflo(qq.x); qf[1] = bfhi(qq.x); qf[2] = bflo(qq.y); qf[3] = bfhi(qq.y); qf[4] = bflo(qq.z); qf[5] = bfhi(qq.z); qf[6] = bflo(qq.w); qf[7] = bfhi(qq.w);
            u32x4 qo, ko;
            qo.x = pk2(qf[0] * eb[0], qf[1] * eb[1]); qo.y = pk2(qf[2] * eb[2], qf[3] * eb[3]); qo.z = pk2(qf[4] * eb[4], qf[5] * eb[5]); qo.w = pk2(qf[6] * eb[6], qf[7] * eb[7]);
            ko.x = pk2(kf[0] * frcp(eb[0]), kf[1] * frcp(eb[1])); ko.y = pk2(kf[2] * frcp(eb[2]), kf[3] * frcp(eb[3])); ko.z = pk2(kf[4] * frcp(eb[4]), kf[5] * frcp(eb[5])); ko.w = pk2(kf[6] * frcp(eb[6]), kf[7] * frcp(eb[7]));
            *(LAS u32x4*)(Qs + r * 136 + c16 + 8 * q) = qo; *(LAS u32x4*)(Ks + r * 136 + c16 + 8 * q) = ko;
            const unsigned vw[4] = {vq.x, vq.y, vq.z, vq.w};
#pragma unroll
            for (int i = 0; i < 4; ++i) { const int cc = c16 + 8 * q + 2 * i; VT[cc * 72 + r] = (bf16_t)(vw[i] & 0xffffu); VT[(cc + 1) * 72 + r] = (bf16_t)(vw[i] >> 16); }
        }
        { const u32x4* sp = (const u32x4*)(ST + (size_t)u * 16384);
#pragma unroll
            for (int i = 0; i < 4; ++i) { const int idx = tid + 512 * i; *(LAS u32x4*)(Ss + (idx >> 4) * 136 + (idx & 15) * 8) = sp[idx]; } }
        __syncthreads();
        const int tt = w & 1, dvt = w >> 1;
        f32x16 o = zero16();
#pragma unroll
        for (int ks = 0; ks < 8; ++ks) {
            const bf16x8 a = *(const LAS bf16x8*)(Ss + (dvt * 32 + r32) * 136 + ks * 16 + hh * 8);
            const bf16x8 b = *(const LAS bf16x8*)(Qs + (tt * 32 + r32) * 136 + ks * 16 + hh * 8);
            o = mfma32(a, b, o);
        }
#pragma unroll
        for (int st = 0; st < 2; ++st) {
            if (st <= tt) {
                f32x16 pp = zero16();
#pragma unroll
                for (int ks = 0; ks < 8; ++ks) {
                    const bf16x8 a = *(const LAS bf16x8*)(Ks + (st * 32 + r32) * 136 + ks * 16 + hh * 8);
                    const bf16x8 b = *(const LAS bf16x8*)(Qs + (tt * 32 + r32) * 136 + ks * 16 + hh * 8);
                    pp = mfma32(a, b, pp);
                }
                if (st == tt) {
#pragma unroll
                    for (int reg = 0; reg < 16; ++reg) { const int sl = (reg & 3) + 8 * (reg >> 2) + 4 * hh; if (sl > r32) pp[reg] = 0.f; }
                }
#pragma unroll
                for (int s2 = 0; s2 < 2; ++s2) {
                    u32x4 pb; pb.x = pk2(pp[8 * s2 + 0], pp[8 * s2 + 1]); pb.y = pk2(pp[8 * s2 + 2], pp[8 * s2 + 3]); pb.z = pk2(pp[8 * s2 + 4], pp[8 * s2 + 5]); pb.w = pk2(pp[8 * s2 + 6], pp[8 * s2 + 7]);
                    const LAS bf16_t* vp = VT + (dvt * 32 + r32) * 72 + st * 32 + 16 * s2 + 4 * hh;
                    const u32x2 va = *(const LAS u32x2*)vp, vb = *(const LAS u32x2*)(vp + 8);
                    u32x4 av; av.x = va.x; av.y = va.y; av.z = vb.x; av.w = vb.y;
                    o = mfma32(__builtin_bit_cast(bf16x8, av), __builtin_bit_cast(bf16x8, pb), o);
                }
            }
        }
        float ss = 0.f;
#pragma unroll
        for (int reg = 0; reg < 16; ++reg) ss += o[reg] * o[reg];
        ss += __shfl_xor(ss, 32);
        if (hh == 0) red[(tt * 32 + r32) * 4 + dvt] = ss;
        __syncthreads();
        { const int t = tt * 32 + r32; const f32x4 rr = *(const LAS f32x4*)(red + t * 4); const float rsn = rsqrtf(((rr[0] + rr[1]) + (rr[2] + rr[3])) * (1.f / 128.f) + EPS);
            if (t < hu.L) {
                const bf16_t* gp = GG + (size_t)(lrow0 + t) * D + hu.h * 128; bf16_t* op = O2 + (size_t)(hu.row0 + t) * D + hu.h * 128;
#pragma unroll
                for (int g4 = 0; g4 < 4; ++g4) { const int dv = dvt * 32 + 8 * g4 + 4 * hh;
                    const u32x2 gv = *(const u32x2*)(gp + dv); const f32x4 gw = *(const f32x4*)(gnorm + hu.h * 128 + dv);
                    u32x2 ov; ov.x = pk2(o[4 * g4 + 0] * rsn * gw[0] * bflo(gv.x), o[4 * g4 + 1] * rsn * gw[1] * bfhi(gv.x));
                    ov.y = pk2(o[4 * g4 + 2] * rsn * gw[2] * bflo(gv.y), o[4 * g4 + 3] * rsn * gw[3] * bfhi(gv.y));
                    *(u32x2*)(op + dv) = ov; }
            } }
        __syncthreads();
    }
}

__device__ __forceinline__ void attn_phase(LAS unsigned char* lds, KP p) {
    const int tid = o_tid(), lane = tid & 63, w = tid >> 6, r32 = lane & 31, hh = lane >> 5;
    LAS bf16_t* Ks = (LAS bf16_t*)lds; LAS bf16_t* VT = Ks + 192 * 72;
    const bf16_t* Kb = (const bf16_t*)(p->ws + WS_KB); const bf16_t* Vb = (const bf16_t*)(p->ws + WS_VB); const bf16_t* Qb = (const bf16_t*)(p->ws + WS_QB);
    bf16_t* O = (bf16_t*)(p->ws + WS_O);
    const float* sinks = p->in[18];
    const int bidx = o_bid(), gdim = o_grid();
    for (int u = bidx; u < 2048 + 64; u += gdim) {
        int qrow0, krow0, nk, kvh, L, sb = -1;
        if (u < 2048) { const int b = u >> 9, c = (u >> 2) & 127; kvh = u & 3; const int c0 = c < 2 ? 0 : c - 2; qrow0 = b * TP + 64 * c; krow0 = b * TP + 64 * c0; nk = (c - c0 + 1) * 64; L = 64; }
        else { const int uu = u - 2048; sb = uu >> 2; kvh = uu & 3; qrow0 = MP + 32 * sb; krow0 = qrow0 - 128; nk = 160; L = 32; }
        for (int idx = tid; idx < nk * 8; idx += 512) { const int s = idx >> 3, p8 = (idx & 7) * 8;
            u32x4 kq, vq;
            if (sb >= 0 && s < 128) { const float* kp = p->in[3] + ((size_t)(sb * 128 + s) * 4 + kvh) * 64 + p8; const float* vp = p->in[4] + ((size_t)(sb * 128 + s) * 4 + kvh) * 64 + p8;
                kq = pack8(*(const f32x4*)kp, *(const f32x4*)(kp + 4)); vq = pack8(*(const f32x4*)vp, *(const f32x4*)(vp + 4)); }
            else { kq = *(const u32x4*)(Kb + (size_t)(krow0 + s) * 256 + kvh * 64 + p8); vq = *(const u32x4*)(Vb + (size_t)(krow0 + s) * 256 + kvh * 64 + p8); }
            *(LAS u32x4*)(Ks + s * 72 + p8) = kq;
            const unsigned vw[4] = {vq.x, vq.y, vq.z, vq.w};
#pragma unroll
            for (int i = 0; i < 4; ++i) { VT[(p8 + 2 * i) * 200 + s] = (bf16_t)(vw[i] & 0xffffu); VT[(p8 + 2 * i + 1) * 200 + s] = (bf16_t)(vw[i] >> 16); }
        }
        __syncthreads();
        const int g = w >> 1, tt = w & 1, qh = kvh * 4 + g, nst = nk >> 5;
        if (tt * 32 < L) {
            const int t = tt * 32 + r32;
            bf16x8 qf[4];
#pragma unroll
            for (int ks = 0; ks < 4; ++ks) qf[ks] = *(const bf16x8*)(Qb + (size_t)(qrow0 + t) * D + qh * 64 + ks * 16 + hh * 8);
            f32x16 pp[6];
            const float sink = sinks[qh];
            float mx = sink;
#pragma unroll
            for (int st = 0; st < 6; ++st) {
                pp[st] = zero16();
                if (st < nst) {
#pragma unroll
                    for (int ks = 0; ks < 4; ++ks) pp[st] = mfma32(*(const LAS bf16x8*)(Ks + (st * 32 + r32) * 72 + ks * 16 + hh * 8), qf[ks], pp[st]);
#pragma unroll
                    for (int reg = 0; reg < 16; ++reg) mx = fmaxf(mx, pp[st][reg]);
                }
            }
            mx = fmaxf(mx, __shfl_xor(mx, 32));
            float sum = 0.f;
#pragma unroll
            for (int st = 0; st < 6; ++st) if (st < nst) {
#pragma unroll
                for (int reg = 0; reg < 16; ++reg) { const float e = __expf(pp[st][reg] - mx); pp[st][reg] = e; sum += e; } }
            sum += __shfl_xor(sum, 32);
            const float inv = frcp(sum + __expf(sink - mx));
            f32x16 o0 = zero16(), o1 = zero16();
#pragma unroll
            for (int st = 0; st < 6; ++st) if (st < nst) {
#pragma unroll
                for (int s2 = 0; s2 < 2; ++s2) {
                    u32x4 pb; pb.x = pk2(pp[st][8 * s2 + 0], pp[st][8 * s2 + 1]); pb.y = pk2(pp[st][8 * s2 + 2], pp[st][8 * s2 + 3]); pb.z = pk2(pp[st][8 * s2 + 4], pp[st][8 * s2 + 5]); pb.w = pk2(pp[st][8 * s2 + 6], pp[st][8 * s2 + 7]);
                    const bf16x8 pbv = __builtin_bit_cast(bf16x8, pb);
                    { const LAS bf16_t* vp = VT + r32 * 200 + st * 32 + 16 * s2 + 4 * hh; const u32x2 va = *(const LAS u32x2*)vp, vb = *(const LAS u32x2*)(vp + 8);
                      u32x4 av; av.x = va.x; av.y = va.y; av.z = vb.x; av.w = vb.y; o0 = mfma32(__builtin_bit_cast(bf16x8, av), pbv, o0); }
                    { const LAS bf16_t* vp = VT + (32 + r32) * 200 + st * 32 + 16 * s2 + 4 * hh; const u32x2 va = *(const LAS u32x2*)vp, vb = *(const LAS u32x2*)(vp + 8);
                      u32x4 av; av.x = va.x; av.y = va.y; av.z = vb.x; av.w = vb.y; o1 = mfma32(__builtin_bit_cast(bf16x8, av), pbv, o1); }
                }
            }
            bf16_t* op = O + (size_t)(qrow0 + t) * D + qh * 64;
#pragma unroll
            for (int g4 = 0; g4 < 4; ++g4) { const int dv = 8 * g4 + 4 * hh;
                u32x2 a; a.x = pk2(o0[4 * g4] * inv, o0[4 * g4 + 1] * inv); a.y = pk2(o0[4 * g4 + 2] * inv, o0[4 * g4 + 3] * inv); *(u32x2*)(op + dv) = a;
                u32x2 b; b.x = pk2(o1[4 * g4] * inv, o1[4 * g4 + 1] * inv); b.y = pk2(o1[4 * g4 + 2] * inv, o1[4 * g4 + 3] * inv); *(u32x2*)(op + 32 + dv) = b; }
        }
        __syncthreads();
    }
}

constexpr int XR = 4;
template <int MODE, bool LAST>
__device__ __forceinline__ void x_store_row(KP p, int row, int lane, f32x4 (&v)[4], float s) {
    if (LAST) { f32x4* o = (f32x4*)(p->out + OUT_Y + (size_t)row * D) + lane;
#pragma unroll
        for (int j = 0; j < 4; ++j) o[64 * j] = v[j];
    } else {
        u32x2* ob = (u32x2*)((bf16_t*)(p->ws + WS_XB) + (size_t)row * D) + lane;
#pragma unroll
        for (int j = 0; j < 4; ++j) { u32x2 wb; wb.x = pk2(v[j][0], v[j][1]); wb.y = pk2(v[j][2], v[j][3]); ob[64 * j] = wb; }
        s = wave_sum(s);
        if (lane == 0) ((float*)(p->ws + WS_RS))[row] = rsqrtf(s * (1.f / D) + EPS);
    }
}
template <int MODE, bool LAST>
__device__ __forceinline__ void x_phase(KP p, const float* wpost, int nsplit) {
    const int tid = o_tid(), lane = tid & 63, wave = tid >> 6;
    const int gw = o_bid() * 8 + wave, NGW = o_grid() * 8;
    const bf16_t* MIX = (const bf16_t*)(p->ws + WS_MIX); const float* SSQ = (const float*)(p->ws + WS_SSQ);
    const bf16_t* XB = (const bf16_t*)(p->ws + WS_XB);
    f32x4 wv[4];
#pragma unroll
    for (int j = 0; j < 4; ++j) wv[j] = *((const f32x4*)wpost + lane + 64 * j);
    for (int row0 = gw; row0 < MP; row0 += XR * NGW) {
        f32x4 v[XR][4]; u32x2 mm[XR][4]; float tot[XR]; bool ok[XR];
#pragma unroll
        for (int q = 0; q < XR; ++q) { const int row = row0 + q * NGW; ok[q] = row < MP; const int rr = ok[q] ? row : row0;
            tot[q] = SSQ[(size_t)rr * 16 + (lane & 15)];
            const u32x2* mr = (const u32x2*)(MIX + (size_t)rr * D) + lane;
#pragma unroll
            for (int j = 0; j < 4; ++j) mm[q][j] = mr[64 * j];
            if (MODE == 0) { const f32x4* xr = (const f32x4*)(p->in[0] + (size_t)rr * D) + lane;
#pragma unroll
                for (int j = 0; j < 4; ++j) v[q][j] = xr[64 * j]; }
            else { const u32x2* xr = (const u32x2*)(XB + (size_t)rr * D) + lane;
#pragma unroll
                for (int j = 0; j < 4; ++j) { const u32x2 xx = xr[64 * j]; v[q][j] = (f32x4){bflo(xx.x), bfhi(xx.x), bflo(xx.y), bfhi(xx.y)}; } }
        }
#pragma unroll
        for (int q = 0; q < XR; ++q) { const int row = row0 + q * NGW;
            float t = tot[q]; t += __shfl_xor(t, 1); t += __shfl_xor(t, 2); t += __shfl_xor(t, 4); t += __shfl_xor(t, 8);
            const float rsm = rsqrtf(t * (1.f / D) + EPS);
            float s = 0.f;
#pragma unroll
            for (int j = 0; j < 4; ++j) { const u32x2 m2 = mm[q][j];
                v[q][j][0] += bflo(m2.x) * rsm * wv[j][0]; v[q][j][1] += bfhi(m2.x) * rsm * wv[j][1]; v[q][j][2] += bflo(m2.y) * rsm * wv[j][2]; v[q][j][3] += bfhi(m2.y) * rsm * wv[j][3];
                s += (v[q][j][0] * v[q][j][0] + v[q][j][1] * v[q][j][1]) + (v[q][j][2] * v[q][j][2] + v[q][j][3] * v[q][j][3]); }
            if (ok[q]) x_store_row<MODE, LAST>(p, row, lane, v[q], s);
        }
    }
    if (gw < MS) {
        const int row = MP + gw;
        f32x4 v[4], m[4];
        if (MODE == 0) { const f32x4* xr = (const f32x4*)(p->in[1] + (size_t)gw * D) + lane;
#pragma unroll
            for (int j = 0; j < 4; ++j) v[j] = xr[64 * j]; }
        else { const u32x2* xr = (const u32x2*)(XB + (size_t)row * D) + lane;
#pragma unroll
            for (int j = 0; j < 4; ++j) { const u32x2 xx = xr[64 * j]; v[j] = (f32x4){bflo(xx.x), bfhi(xx.x), bflo(xx.y), bfhi(xx.y)}; } }
#pragma unroll
        for (int j = 0; j < 4; ++j) m[j] = (f32x4){0.f, 0.f, 0.f, 0.f};
        const f32x4* pp = (const f32x4*)((const float*)(p->ws + WS_PART) + (size_t)gw * D) + lane;
        for (int ks = 0; ks < nsplit; ++ks) {
#pragma unroll
            for (int j = 0; j < 4; ++j) m[j] += pp[(size_t)ks * (MS * D / 4) + 64 * j]; }
        float ss = 0.f;
#pragma unroll
        for (int j = 0; j < 4; ++j) ss += (m[j][0] * m[j][0] + m[j][1] * m[j][1]) + (m[j][2] * m[j][2] + m[j][3] * m[j][3]);
        ss = wave_sum(ss);
        const float rsm = rsqrtf(ss * (1.f / D) + EPS);
        float s = 0.f;
#pragma unroll
        for (int j = 0; j < 4; ++j) { v[j] += m[j] * rsm * wv[j]; s += (v[j][0] * v[j][0] + v[j][1] * v[j][1]) + (v[j][2] * v[j][2] + v[j][3] * v[j][3]); }
        x_store_row<MODE, LAST>(p, row, lane, v, s);
    }
}

#define XB_TMO      128
#define XB_XCNT(j)  (256  + 64 * (j))
#define XB_XSUB(j)  (1280 + 64 * (j))
#define XB_XGEN(j)  (2304 + 64 * (j))
#define XB_TOP      3328
#define XB_TOPGEN   3392
#define XCD_BAR_WORDS 3456
#define XB_SPIN_CAP (1u << 20)
__device__ __forceinline__ unsigned xb_ld(unsigned* p)              { return __hip_atomic_load(p, __ATOMIC_RELAXED, __HIP_MEMORY_SCOPE_AGENT); }
__device__ __forceinline__ unsigned xb_add(unsigned* p, unsigned v) { return __hip_atomic_fetch_add(p, v, __ATOMIC_RELAXED, __HIP_MEMORY_SCOPE_AGENT); }
__device__ __forceinline__ unsigned xb_xcc_id() { return (unsigned)__builtin_amdgcn_s_getreg((3 << 11) | 20) & 0xFu; }
#define XB_SPIN(cond, bar) do { unsigned _sp = 0; while (cond) { __builtin_amdgcn_s_sleep(1); \
    if ((++_sp & 255u) == 0u) { if (xb_ld(&(bar)[XB_TMO])) break; if (_sp > XB_SPIN_CAP) { atomicAdd(&(bar)[XB_TMO], 1u); break; } } } } while (0)
struct XcdBarrier { unsigned* bar; unsigned x; volatile LAS unsigned* st; };
__device__ __forceinline__ XcdBarrier xcd_barrier_post(unsigned* bar, volatile LAS unsigned* st) {
    XcdBarrier b; b.bar = bar; b.x = xb_xcc_id(); b.st = st;
    if (threadIdx.x == 0) (void)xb_add(&bar[XB_XCNT(b.x)], 1u);
    return b;
}
__device__ __forceinline__ void xcd_barrier_complete(unsigned* bar, unsigned x, unsigned& nloc, unsigned& nx) {
    const unsigned G = gridDim.x * gridDim.y * gridDim.z;
    unsigned sum, cnt, mine, sp = 0u;
    for (;;) {
        sum = 0u; cnt = 0u; mine = 0u;
#pragma unroll
        for (unsigned j = 0; j < 16; ++j) { const unsigned c = xb_ld(&bar[XB_XCNT(j)]); sum += c; cnt += (c > 0u) ? 1u : 0u; mine = (j == x) ? c : mine; }
        if (sum == G) break;
        __builtin_amdgcn_s_sleep(1);
        if ((++sp & 255u) == 0u) { if (xb_ld(&bar[XB_TMO])) break; if (sp > XB_SPIN_CAP) { atomicAdd(&bar[XB_TMO], 1u); break; } }
    }
    nloc = mine > 0u ? mine : 1u; nx = cnt > 0u ? cnt : 1u;
}
__device__ __forceinline__ void xcd_barrier(const XcdBarrier& b) {
    asm volatile("s_waitcnt vmcnt(0)" ::: "memory");
    __syncthreads();
    if (threadIdx.x == 0) {
        unsigned* bar = b.bar;
        __builtin_amdgcn_s_waitcnt(0);
        unsigned nloc = b.st[0], nx = b.st[1];
        if (nloc == 0u) { xcd_barrier_complete(bar, b.x, nloc, nx); b.st[0] = nloc; b.st[1] = nx; }
        const unsigned old = xb_add(&bar[XB_XSUB(b.x)], 1u);
        const unsigned gen = old / nloc;
        if (old + 1u == (gen + 1u) * nloc) {
            __builtin_amdgcn_fence(__ATOMIC_RELEASE, "agent");
            asm volatile("s_waitcnt vmcnt(0)" ::: "memory");
            const unsigned og = xb_add(&bar[XB_TOP], 1u);
            const unsigned tg = og / nx;
            if (og + 1u == (tg + 1u) * nx) xb_add(&bar[XB_TOPGEN], 1u);
            else XB_SPIN(xb_ld(&bar[XB_TOPGEN]) == tg, bar);
            __builtin_amdgcn_fence(__ATOMIC_ACQUIRE, "agent");
            xb_add(&bar[XB_XGEN(b.x)], 1u);
            asm volatile("s_waitcnt vmcnt(0)" ::: "memory");
        } else {
            XB_SPIN(xb_ld(&bar[XB_XGEN(b.x)]) == gen, bar);
            __builtin_amdgcn_fence(__ATOMIC_ACQUIRE, "agent");
            asm volatile("s_waitcnt vmcnt(0)" ::: "memory");
        }
    }
    __syncthreads();
}

constexpr int NPHASE = 21;
__global__ void __launch_bounds__(512, 2) mega(Params p_arg, int ph_lo, int ph_hi) {
    extern __shared__ __attribute__((aligned(16))) unsigned char lds_raw[];
    LAS unsigned char* lds = (LAS unsigned char*)lds_raw;
    cg::grid_group grid = cg::this_grid();
    if (threadIdx.x < 4) ((LAS unsigned*)(lds + 131072))[threadIdx.x] = 0u;
    __syncthreads();
    const XcdBarrier xbar = xcd_barrier_post((unsigned*)(kparams()->ws + WS_BAR), (volatile LAS unsigned*)(lds + 131072));
    if (ph_lo < 0) grid.sync();
#define G o_grid()
#define bid o_bid()
#define p kparams()
#define ws (kparams()->ws)
#define p kparams()
#define ws (kparams()->ws)
#pragma unroll 1
    for (int ph = ph_lo; ph < ph_hi; ++ph) {
        if (ph == 0) p0_prologue(lds, p);
        else if (ph <= 8) {
            const int hf = (ph - 1) >> 2, sub = (ph - 1) & 3, rowbase = hf ? 16384 : 0, rows = hf ? 16896 : 16384;
            if (sub == 0) {
                pg8::Gemm g{(const bf16_t*)(ws + WS_XB) + (size_t)rowbase * D, (const bf16_t*)(ws + WS_W1), rows, 4096, 1024}; pg8::SplitOrder S; S.init(rows, 4096, o_grid(), o_bid(), 16, 0);
                Epi1 E{ws, rowbase}; pg8::gemm_phase<Epi1>(lds, g, S, E);
            } else if (sub == 1) h1_phase(lds, p, hf);
            else if (sub == 2) h2_phase(p, hf);
            else h3_phase(lds, p, hf);
        } else if (ph == 9 || ph == 12 || ph == 16 || ph == 19) {
            const size_t aoff = ph == 9 ? WS_XB : (ph == 16 ? WS_O : WS_H), woff = ph == 9 ? WS_W2 : (ph == 12 ? WS_W4 : (ph == 16 ? WS_W6 : WS_W8));
            const int K = (ph == 12 || ph == 19) ? DFF : 1024;
            pg8::Gemm g{(const bf16_t*)(ws + aoff), (const bf16_t*)(ws + woff), MT, 1024, K}; pg8::SplitOrder S; S.init(MP, 1024, o_grid(), o_bid(), K / 64, K / 256);
            Epi2 E{ws}; pg8::gemm_phase<Epi2>(lds, g, S, E);
        } else if (ph == 11 || ph == 18) {
            pg8::Gemm g{(const bf16_t*)(ws + WS_XB), (const bf16_t*)(ws + (ph == 18 ? WS_W7 : WS_W3)), MT, 2 * DFF, 1024}; pg8::SplitOrder S; S.init(MT, 2 * DFF, o_grid(), o_bid(), 16, 0);
            Epi3 E{ws}; pg8::gemm_phase<Epi3>(lds, g, S, E);
        } else if (ph == 10) x_phase<0, false>(p, p->in[6], 4);
        else if (ph == 13 || ph == 17) x_phase<1, false>(p, ph == 13 ? p->in[8] : p->in[6] + D, ph == 13 ? 11 : 4);
        else if (ph == 14) {
            pg8::Gemm g{(const bf16_t*)(ws + WS_XB), (const bf16_t*)(ws + WS_W5), MT, 1536, 1024}; pg8::SplitOrder S; S.init(MT, 1536, o_grid(), o_bid(), 16, 0);
            Epi5 E{ws, p->out}; pg8::gemm_phase<Epi5>(lds, g, S, E);
        } else if (ph == 15) attn_phase(lds, p);
        else if (ph == 20) x_phase<1, true>(p, p->in[8] + D, 11);
        if (ph + 1 < ph_hi) xcd_barrier(xbar);
    }
#undef p
#undef ws
}

extern "C" void kernel_launch(void* const* d_in, const int* in_sizes, int n_in, void* d_out, int out_size, void* d_ws, size_t ws_size, hipStream_t stream) {
    static int grid = 0;
    if (!grid) {
        if (n_in != 20 || ws_size < WS_END) { fprintf(stderr, "kernel_launch: unexpected n_in %d / ws_size %zu (need %zu)\n", n_in, ws_size, (size_t)WS_END); return; }
        int dev = 0, cus = 0, per_cu = 0;
        hipGetDevice(&dev); hipDeviceGetAttribute(&cus, hipDeviceAttributeMultiprocessorCount, dev);
        hipFuncSetAttribute((const void*)mega, hipFuncAttributeMaxDynamicSharedMemorySize, LDS_BYTES);
        hipOccupancyMaxActiveBlocksPerMultiprocessor(&per_cu, (const void*)mega, 512, LDS_BYTES);
        if (per_cu < 1) { fprintf(stderr, "kernel_launch: occupancy query says %d blocks per CU\n", per_cu); per_cu = 1; }
        grid = cus * 1;
    }
    Params p{};
    for (int i = 0; i < 20; ++i) p.in[i] = (const float*)d_in[i];
    p.out = (float*)d_out; p.ws = (unsigned char*)d_ws;
    if (hipMemsetAsync((unsigned char*)d_ws + WS_BAR, 0, BAR_BYTES, stream) != hipSuccess) { fprintf(stderr, "kernel_launch: memset of the barrier words failed\n"); return; }
#if MK_ONE_LAUNCH
    int lo = 0, hi = NPHASE;
    void* args[] = {&p, &lo, &hi};
    hipError_t e = hipLaunchCooperativeKernel((const void*)mega, dim3(grid), dim3(512), args, LDS_BYTES, stream);
    if (e != hipSuccess) fprintf(stderr, "cooperative launch failed: %s (grid %d)\n", hipGetErrorString(e), grid);
#else
    for (int ph = 0; ph < NPHASE; ++ph) { hipLaunchKernelGGL(mega, dim3(grid), dim3(512), LDS_BYTES, stream, p, ph, ph + 1);
        if ((PROBE_DUP >> ph) & 1) for (int r = 0; r < PROBE_REP; ++r) hipLaunchKernelGGL(mega, dim3(grid), dim3(512), LDS_BYTES, stream, p, ph, ph + 1); }
#endif
}
```
